# Optimizing an MI355X kernel written in HIP

```python
import math
import jax, jax.numpy as jnp
from jax import lax
import numpy as np

D_MODEL = 1024
BATCH = 16
SEQ = 2048
DEPTH = 1

HEAD_DIM = 64
N_HEADS_MOBA = 8
N_HEADS_SB = 8
WIDTH_MOBA = N_HEADS_MOBA * HEAD_DIM
WIDTH_SB = N_HEADS_SB * HEAD_DIM
MOBA_BLOCK = 256
MOBA_TOPK = 3
MOBA_Q_CHUNK = 16
SB_Q_BLOCK = 128
REL_BUCKETS = 32
REL_MAX_DIST = 128
NORM_EPS = 1e-6
NEG_INF = -1e30
PROJ_SPLITS = [WIDTH_MOBA] * 4 + [WIDTH_SB] * 4 + [D_MODEL] * 2
IN_WIDTH = sum(PROJ_SPLITS)
SPLIT_POINTS = [int(c) for c in np.cumsum(PROJ_SPLITS)[:-1]]

kernel_name = "hybrid_moba_stickbreaking_block"


def rms_norm(x, w):
    xf = x.astype(jnp.float32)
    y = xf * lax.rsqrt(jnp.mean(xf * xf, axis=-1, keepdims=True) + NORM_EPS)
    return (y * w.astype(jnp.float32)).astype(x.dtype)


def split_heads(t, n_heads):
    b, s, _ = t.shape
    return t.reshape(b, s, n_heads, HEAD_DIM).transpose(0, 2, 1, 3)


def merge_heads(t):
    b, h, s, dh = t.shape
    return t.transpose(0, 2, 1, 3).reshape(b, s, h * dh)


def t5_bucket(dist):
    n = jnp.maximum(dist, 0)
    max_exact = REL_BUCKETS // 2
    nf = jnp.maximum(n, 1).astype(jnp.float32)
    large = max_exact + (jnp.log(nf / max_exact) / math.log(REL_MAX_DIST / max_exact)
                         * (REL_BUCKETS - max_exact)).astype(jnp.int32)
    large = jnp.minimum(large, REL_BUCKETS - 1)
    return jnp.where(n < max_exact, n, large)


def moba_attention(q, k, v, rel_bias):
    b, h, s, dh = q.shape
    nb = -(-s // MOBA_BLOCK)
    s_pad = nb * MOBA_BLOCK
    top = min(MOBA_TOPK, nb)
    scale = dh ** -0.5
    pad = ((0, 0), (0, 0), (0, s_pad - s), (0, 0))
    q, k, v = jnp.pad(q, pad), jnp.pad(k, pad), jnp.pad(v, pad)
    k_blk = k.reshape(b, h, nb, MOBA_BLOCK, dh)
    v_blk = v.reshape(b, h, nb, MOBA_BLOCK, dh)
    k_mean = jnp.mean(k_blk.astype(jnp.float32), axis=3)
    n_chunks = s_pad // MOBA_Q_CHUNK
    q_chunks = q.reshape(b, h, n_chunks, MOBA_Q_CHUNK, dh).transpose(2, 0, 1, 3, 4)
    bi = jnp.arange(b)[:, None, None, None]
    hi = jnp.arange(h)[None, :, None, None]
    offs = jnp.arange(MOBA_BLOCK)
    blk_ids = jnp.arange(nb)

    def one_chunk(args):
        qc, ci = args
        t = ci * MOBA_Q_CHUNK + jnp.arange(MOBA_Q_CHUNK)
        cur = (ci * MOBA_Q_CHUNK) // MOBA_BLOCK
        gate = jnp.einsum('bhqd,bhnd->bhqn', qc.astype(jnp.float32), k_mean)
        gate = jnp.where(blk_ids < cur, gate, NEG_INF)
        _, idx = lax.top_k(gate, top)
        valid = idx < cur
        k_sel = k_blk[bi, hi, idx]
        v_sel = v_blk[bi, hi, idx]
        pos_sel = idx[..., None] * MOBA_BLOCK + offs
        bias_sel = rel_bias[hi[..., None], t5_bucket(t[:, None, None] - pos_sel)]
        logit_sel = jnp.einsum('bhqd,bhqjkd->bhqjk', qc, k_sel).astype(jnp.float32) * scale + bias_sel
        logit_sel = jnp.where(valid[..., None], logit_sel, NEG_INF).reshape(b, h, MOBA_Q_CHUNK, top * MOBA_BLOCK)
        k_own = lax.dynamic_index_in_dim(k_blk, cur, axis=2, keepdims=False)
        v_own = lax.dynamic_index_in_dim(v_blk, cur, axis=2, keepdims=False)
        dist_own = t[:, None] - (cur * MOBA_BLOCK + offs)[None, :]
        bias_own = rel_bias[:, t5_bucket(dist_own)]
        logit_own = jnp.einsum('bhqd,bhkd->bhqk', qc, k_own).astype(jnp.float32) * scale + bias_own
        logit_own = jnp.where(dist_own >= 0, logit_own, NEG_INF)
        p = jax.nn.softmax(jnp.concatenate([logit_sel, logit_own], axis=-1), axis=-1).astype(v.dtype)
        p_sel = p[..., :top * MOBA_BLOCK].reshape(b, h, MOBA_Q_CHUNK, top, MOBA_BLOCK)
        p_own = p[..., top * MOBA_BLOCK:]
        return (jnp.einsum('bhqjk,bhqjkd->bhqd', p_sel, v_sel)
                + jnp.einsum('bhqk,bhkd->bhqd', p_own, v_own))

    out = lax.map(one_chunk, (q_chunks, jnp.arange(n_chunks)))
    out = out.transpose(1, 2, 0, 3, 4).reshape(b, h, s_pad, dh)
    return out[:, :, :s]


def stick_breaking_attention(q, k, v):
    s_len = q.shape[2]
    scale = q.shape[-1] ** -0.5
    outs = []
    for i in range(s_len // SB_Q_BLOCK):
        t0, t1 = i * SB_Q_BLOCK, (i + 1) * SB_Q_BLOCK
        z = jnp.einsum('bhqd,bhkd->bhqk', q[:, :, t0:t1], k[:, :, :t1]).astype(jnp.float32) * scale
        past = jnp.arange(t1)[None, :] < (t0 + jnp.arange(SB_Q_BLOCK))[:, None]
        log_1m = jnp.where(past, jax.nn.log_sigmoid(-z), 0.0)
        shifted = jnp.concatenate([log_1m[..., 1:], jnp.zeros_like(log_1m[..., :1])], axis=-1)
        suffix = lax.cumsum(shifted, axis=3, reverse=True)
        w = jnp.where(past, jnp.exp(jax.nn.log_sigmoid(z) + suffix), 0.0).astype(v.dtype)
        outs.append(jnp.einsum('bhqk,bhkd->bhqd', w, v[:, :, :t1]))
    return jnp.concatenate(outs, axis=2)


def setup_inputs(seed: int = 0) -> dict:
    key = jax.random.key(seed)
    ks = jax.random.split(key, 10)
    f32 = jnp.float32
    x = jax.random.normal(ks[0], (BATCH, SEQ, D_MODEL), f32)
    norm_w = 1.0 + 0.02 * jax.random.normal(ks[1], (DEPTH, D_MODEL), f32)
    w_in = jax.random.normal(ks[2], (DEPTH, D_MODEL, IN_WIDTH), f32) * D_MODEL ** -0.5
    merge_gate_b = 0.01 * jax.random.normal(ks[3], (DEPTH, 2 * D_MODEL), f32)
    q_norm_w = 1.0 + 0.02 * jax.random.normal(ks[4], (DEPTH, HEAD_DIM), f32)
    k_norm_w = 1.0 + 0.02 * jax.random.normal(ks[5], (DEPTH, HEAD_DIM), f32)
    rel_bias = 0.2 * jax.random.normal(ks[6], (N_HEADS_MOBA, REL_BUCKETS), f32)
    w_up_moba = jax.random.normal(ks[7], (DEPTH, WIDTH_MOBA, D_MODEL), f32) * WIDTH_MOBA ** -0.5
    w_up_sb = jax.random.normal(ks[8], (DEPTH, WIDTH_SB, D_MODEL), f32) * WIDTH_SB ** -0.5
    w_out = jax.random.normal(ks[9], (DEPTH, D_MODEL, D_MODEL), f32) * D_MODEL ** -0.5
    return {"x": x, "norm_w": norm_w, "w_in": w_in, "merge_gate_b": merge_gate_b,
            "q_norm_w": q_norm_w, "k_norm_w": k_norm_w, "rel_bias": rel_bias,
            "w_up_moba": w_up_moba, "w_up_sb": w_up_sb, "w_out": w_out}


def reference(x, norm_w, w_in, merge_gate_b, q_norm_w, k_norm_w, rel_bias, w_up_moba, w_up_sb, w_out):
    for l in range(DEPTH):
        h = rms_norm(x, norm_w[l])
        proj = h @ w_in[l]
        qa, ka, va, za, qb, kb, vb, zb, gl_a, gl_b = jnp.split(proj, SPLIT_POINTS, axis=-1)
        qa = rms_norm(split_heads(qa, N_HEADS_MOBA), q_norm_w[l])
        ka = rms_norm(split_heads(ka, N_HEADS_MOBA), k_norm_w[l])
        oa = moba_attention(qa, ka, split_heads(va, N_HEADS_MOBA), rel_bias)
        ob = stick_breaking_attention(split_heads(qb, N_HEADS_SB), split_heads(kb, N_HEADS_SB),
                                      split_heads(vb, N_HEADS_SB))
        ya = (merge_heads(oa) * jax.nn.silu(za)) @ w_up_moba[l]
        yb = (merge_heads(ob) * jax.nn.silu(zb)) @ w_up_sb[l]
        gb = merge_gate_b[l]
        y = jax.nn.sigmoid(gl_a + gb[:D_MODEL]) * ya + jax.nn.sigmoid(gl_b + gb[D_MODEL:]) * yb
        x = x + y @ w_out[l]
    return x
```

```cpp
#include <hip/hip_runtime.h>
#include <cstdint>
#include <cstdio>

namespace cfg {
constexpr int BATCH = 16, SEQ = 2048, DM = 1024, M = BATCH * SEQ;
constexpr int NH = 8, HD = 64, W = 512, INW = 6144;
constexpr int MBLK = 256, NBLK = SEQ / MBLK, TOPK = 3;
constexpr float EPS = 1e-6f;
constexpr float LOG2E = 1.4426950408889634f;
constexpr float C2 = 0.125f * LOG2E;
constexpr size_t MiB = 1u << 20;
constexpr size_t WS_CTL = 0, CTL_ZERO_BYTES = 1 * MiB, WS_KSUM = 512 * 1024;
constexpr size_t WS_WIN = 2 * MiB, WS_WUP = 14 * MiB, WS_WOUT = 16 * MiB;
constexpr size_t WS_H = 20 * MiB;
constexpr size_t WS_P = 84 * MiB;
constexpr size_t WS_GA = 340 * MiB, WS_GB = 404 * MiB;
constexpr size_t WS_Y = 84 * MiB;
constexpr size_t WS_Y1 = 148 * MiB;
constexpr size_t WS_END = 468 * MiB;
}
using namespace cfg;
typedef unsigned short bf16;

__device__ __forceinline__ float bf2f(bf16 v) { return __uint_as_float((unsigned)v << 16); }
__device__ __forceinline__ bf16 f2bf(float f) { unsigned u = __float_as_uint(f); return (bf16)((u + 0x7fffu + ((u >> 16) & 1u)) >> 16); }
__host__ __device__ __forceinline__ int phys_of_actual(int col) { const int a = col & 255; return (col & ~255) + 128 * ((a >> 5) & 1) + 32 * (a >> 6) + (a & 31); }
__host__ __device__ __forceinline__ int actual_of_phys(int row) { const int p = row & 255; return (row & ~255) + 64 * ((p >> 5) & 3) + 32 * (p >> 7) + (p & 31); }

__constant__ unsigned char T5B[128] = {0, 1, 2, 3, 4, 5, 6, 7, 8, 9, 10, 11, 12, 13, 14, 15, 16, 16, 16, 17, 17, 18, 18, 18, 19, 19, 19, 20, 20, 20, 20, 21, 21, 21, 21, 22, 22, 22, 22, 22, 23, 23, 23, 23, 23, 23, 24, 24, 24, 24, 24, 24, 25, 25, 25, 25, 25, 25, 25, 26, 26, 26, 26, 26, 26, 26, 26, 27, 27, 27, 27, 27, 27, 27, 27, 27, 27, 28, 28, 28, 28, 28, 28, 28, 28, 28, 28, 29, 29, 29, 29, 29, 29, 29, 29, 29, 29, 29, 29, 30, 30, 30, 30, 30, 30, 30, 30, 30, 30, 30, 30, 30, 30, 31, 31, 31, 31, 31, 31, 31, 31, 31, 31, 31, 31, 31, 31, 31};

__global__ void nv_wprep(const float* W, int K, int N, bf16* Wt, int ldt, int koff) {
    const size_t i = (size_t)blockIdx.x * blockDim.x + threadIdx.x; if (i >= (size_t)K * N) return;
    const int n = (int)(i % N), k = (int)(i / N);
    Wt[(size_t)phys_of_actual(n) * ldt + koff + k] = f2bf(W[i]);
}
__global__ void nv_rmsnorm(const float* x, const float* nw, bf16* h) {
    const int row = blockIdx.x * 4 + (threadIdx.x >> 6), lane = threadIdx.x & 63;
    const float* xr = x + (size_t)row * DM; float s = 0.f;
    for (int j = lane; j < DM; j += 64) s += xr[j] * xr[j];
    for (int o = 1; o < 64; o <<= 1) s += __shfl_xor(s, o);
    const float r = rsqrtf(s * (1.f / DM) + EPS);
    for (int j = lane; j < DM; j += 64) h[(size_t)row * DM + j] = f2bf(xr[j] * r * nw[j]);
}
template <class BR>
__device__ __forceinline__ void nv_tile(const bf16* A, int lda, const bf16* Bt, int ldb, int K, int row0, BR brow, float (&acc)[4][4], float* As, float* Bs) {
    const int tid = threadIdx.x, ty = tid >> 4, tx = tid & 15;
    for (int i = 0; i < 4; ++i) for (int j = 0; j < 4; ++j) acc[i][j] = 0.f;
    for (int k0 = 0; k0 < K; k0 += 32) {
        for (int e = tid; e < 64 * 32; e += 256) { const int r = e >> 5, kk = e & 31;
            As[r * 33 + kk] = bf2f(A[(size_t)(row0 + r) * lda + k0 + kk]); Bs[r * 33 + kk] = bf2f(Bt[(size_t)brow(r) * ldb + k0 + kk]); }
        __syncthreads();
        for (int kk = 0; kk < 32; ++kk) { float a[4], b[4];
            for (int i = 0; i < 4; ++i) { a[i] = As[(ty * 4 + i) * 33 + kk]; b[i] = Bs[(tx * 4 + i) * 33 + kk]; }
            for (int i = 0; i < 4; ++i) for (int j = 0; j < 4; ++j) acc[i][j] += a[i] * b[j]; }
        __syncthreads();
    }
}
struct Ptrs { const float* in[10]; float* out; unsigned char* ws; };
__global__ void __launch_bounds__(256) nv_gemm1(Ptrs P) {
    __shared__ float As[64 * 33], Bs[64 * 33], T[64 * 65], rs[64];
    const int hc = blockIdx.x, row0 = blockIdx.y * 64, tid = threadIdx.x, ty = tid >> 4, tx = tid & 15;
    const bf16* H = (const bf16*)(P.ws + WS_H); const bf16* Wt = (const bf16*)(P.ws + WS_WIN);
    float acc[4][4];
    nv_tile(H, DM, Wt, DM, DM, row0, [&](int c) { return phys_of_actual(hc * 64 + c); }, acc, As, Bs);
    for (int i = 0; i < 4; ++i) for (int j = 0; j < 4; ++j) T[(ty * 4 + i) * 65 + tx * 4 + j] = acc[i][j];
    __syncthreads();
    const int col0 = hc * 64;
    const int g = col0 / 512;
    if (tid < 64) { float s = 0.f; for (int c = 0; c < 64; ++c) s += T[tid * 65 + c] * T[tid * 65 + c]; rs[tid] = rsqrtf(s * (1.f / 64) + EPS); }
    __syncthreads();
    const float* gbias = P.in[3]; const float* qnw = P.in[4]; const float* knw = P.in[5];
    for (int e = tid; e < 4096; e += 256) { const int r = e >> 6, c = e & 63; float v = T[r * 65 + c]; const int row = row0 + r, col = col0 + c;
        if (g < 8) { const int cc = col - g * 512; bf16* dst = (bf16*)(P.ws + WS_P + (size_t)g * 32 * MiB) + (size_t)row * W + cc;
            if (g == 0) v = v * rs[r] * qnw[c] * C2;
            else if (g == 1) { v = v * rs[r] * knw[c]; T[r * 65 + c] = v; }
            else if (g == 3 || g == 7) v = v / (1.f + __expf(-v));
            else if (g == 4) v = v * C2;
            *dst = f2bf(v);
        } else { const int cc = col - 4096; const float s = 1.f / (1.f + __expf(-(v + gbias[cc])));
            if (cc < 1024) ((bf16*)(P.ws + WS_GA))[(size_t)row * DM + cc] = f2bf(s); else ((bf16*)(P.ws + WS_GB))[(size_t)row * DM + cc - 1024] = f2bf(s); }
    }
    if (g == 1) { __syncthreads();
        if (tid < 64) { float s = 0.f; for (int r = 0; r < 64; ++r) s += T[r * 65 + tid];
            const int b = row0 / SEQ, blk = (row0 % SEQ) / MBLK, h = (col0 - 512) / 64;
            atomicAdd((float*)(P.ws + WS_KSUM) + ((size_t)(b * NH + h) * NBLK + blk) * 64 + tid, s); } }
}
__device__ __forceinline__ float nv_dot64(const float* qs, const bf16* kr) {
    float d_ = 0.f;
#pragma unroll
    for (int c = 0; c < 8; ++c) { const uint4 u = *(const uint4*)(kr + c * 8); const float4 qa = *(const float4*)(qs + c * 8), qb = *(const float4*)(qs + c * 8 + 4);
        d_ += qa.x * __uint_as_float(u.x << 16) + qa.y * __uint_as_float(u.x & 0xffff0000u) + qa.z * __uint_as_float(u.y << 16) + qa.w * __uint_as_float(u.y & 0xffff0000u)
            + qb.x * __uint_as_float(u.z << 16) + qb.y * __uint_as_float(u.z & 0xffff0000u) + qb.z * __uint_as_float(u.w << 16) + qb.w * __uint_as_float(u.w & 0xffff0000u); }
    return d_;
}
__global__ void __launch_bounds__(256) nv_moba(Ptrs P) {
    __shared__ __attribute__((aligned(16))) float qsm[4][64];
    const int wv = threadIdx.x >> 6, gw = blockIdx.x * 4 + wv, lane = threadIdx.x & 63; float* qs = qsm[wv];
    const int t = gw % SEQ, h = (gw / SEQ) % NH, b = gw / (SEQ * NH);
    const bf16* QA = (const bf16*)(P.ws + WS_P); const bf16* KA = (const bf16*)(P.ws + WS_P + 32 * MiB); const bf16* VA = (const bf16*)(P.ws + WS_P + 64 * MiB); const bf16* ZA = (const bf16*)(P.ws + WS_P + 96 * MiB);
    const float* ksum = (const float*)(P.ws + WS_KSUM) + (size_t)(b * NH + h) * NBLK * 64; const float* rb = P.in[6] + h * 32;
    const size_t rowb = (size_t)b * SEQ; const int cur = t / MBLK;
    const float ql = bf2f(QA[(rowb + t) * W + h * 64 + lane]); qs[lane] = ql; __syncthreads();
    float g[8];
#pragma unroll
    for (int n = 0; n < 8; ++n) { float s = ql * ksum[n * 64 + lane]; for (int o = 1; o < 64; o <<= 1) s += __shfl_xor(s, o); g[n] = s; }
    unsigned sel = 0;
#pragma unroll
    for (int n = 0; n < 8; ++n) { int cnt = 0;
#pragma unroll
        for (int m = 0; m < 8; ++m) cnt += (m < cur) && ((g[m] > g[n]) || (g[m] == g[n] && m < n));
        if (n < cur && cnt < TOPK) sel |= 1u << n; }
    const float b31 = rb[31];
    float mrun = -1e30f, l = 0.f, acc = 0.f;
    for (int blk = 0; blk <= cur; ++blk) { if (blk < cur && !((sel >> blk) & 1)) continue;
        for (int c = 0; c < 4; ++c) { const int key = blk * MBLK + c * 64 + lane; float s = -1e30f;
            if (key <= t) { const float d_ = nv_dot64(qs, KA + (rowb + key) * W + h * 64);
                const int dist = t - key; const float bias = dist < 128 ? rb[T5B[dist]] : b31; s = d_ + bias * LOG2E; }
            float mx = s; for (int o = 1; o < 64; o <<= 1) mx = fmaxf(mx, __shfl_xor(mx, o));
            if (mx < -1e29f) continue;
            const float mn = fmaxf(mrun, mx), f = exp2f(mrun - mn); const float p = (s < -1e29f) ? 0.f : exp2f(s - mn);
            float ps = p; for (int o = 1; o < 64; o <<= 1) ps += __shfl_xor(ps, o);
            l = l * f + ps; acc *= f; mrun = mn;
            const int kbase = blk * MBLK + c * 64;
            for (int i = 0; i < 64; ++i) { const float pi = __shfl(p, i); if (kbase + i <= t) acc += pi * bf2f(VA[(rowb + kbase + i) * W + h * 64 + lane]); }
        } }
    const float z = bf2f(ZA[(rowb + t) * W + h * 64 + lane]);
    ((bf16*)(P.ws + WS_H))[(rowb + t) * DM + h * 64 + lane] = f2bf(acc / l * z);
}
__global__ void __launch_bounds__(256) nv_sb(Ptrs P) {
    __shared__ __attribute__((aligned(16))) float qsm[4][64];
    const int wv = threadIdx.x >> 6, gw = blockIdx.x * 4 + wv, lane = threadIdx.x & 63; float* qs = qsm[wv];
    const int t = gw % SEQ, h = (gw / SEQ) % NH, b = gw / (SEQ * NH);
    const bf16* QB = (const bf16*)(P.ws + WS_P + 128 * MiB); const bf16* KB = (const bf16*)(P.ws + WS_P + 160 * MiB); const bf16* VB = (const bf16*)(P.ws + WS_P + 192 * MiB); const bf16* ZB = (const bf16*)(P.ws + WS_P + 224 * MiB);
    const size_t rowb = (size_t)b * SEQ;
    qs[lane] = bf2f(QB[(rowb + t) * W + h * 64 + lane]); __syncthreads();
    float carry = 0.f, acc = 0.f;
    for (int c0 = ((t - 1) >> 6) << 6; c0 >= 0 && t > 0; c0 -= 64) { const int key = c0 + lane; float z2 = 0.f, L = 0.f;
        if (key < t) { z2 = nv_dot64(qs, KB + (rowb + key) * W + h * 64); L = fmaxf(z2, 0.f) + log2f(1.f + exp2f(-fabsf(z2))); }
        float I = L;
        for (int o = 1; o < 64; o <<= 1) { const float v = __shfl_down(I, o); if (lane + o < 64) I += v; }
        I += carry;
        const float w = (key < t) ? exp2f(z2 - I) : 0.f;
        carry = __shfl(I, 0);
        for (int i = 0; i < 64; ++i) { const float wi = __shfl(w, i); if (c0 + i < t) acc += wi * bf2f(VB[(rowb + c0 + i) * W + h * 64 + lane]); }
    }
    const float z = bf2f(ZB[(rowb + t) * W + h * 64 + lane]);
    ((bf16*)(P.ws + WS_H))[(rowb + t) * DM + 512 + h * 64 + lane] = f2bf(acc * z);
}
__global__ void __launch_bounds__(256) nv_gemm2(Ptrs P) {
    __shared__ float As[64 * 33], Bs[64 * 33];
    const int col0 = blockIdx.x * 64, row0 = blockIdx.y * 64, tid = threadIdx.x, ty = tid >> 4, tx = tid & 15;
    const bf16* O = (const bf16*)(P.ws + WS_H); const bf16* Wt = (const bf16*)(P.ws + WS_WUP);
    float a1[4][4], a2[4][4];
    nv_tile(O, DM, Wt, DM, W, row0, [&](int c) { return phys_of_actual(col0 + c); }, a1, As, Bs);
    nv_tile(O + 512, DM, Wt + 512, DM, W, row0, [&](int c) { return phys_of_actual(col0 + c); }, a2, As, Bs);
    const bf16* GA = (const bf16*)(P.ws + WS_GA); const bf16* GB = (const bf16*)(P.ws + WS_GB); bf16* Y = (bf16*)(P.ws + WS_Y);
    for (int i = 0; i < 4; ++i) for (int j = 0; j < 4; ++j) { const size_t o = (size_t)(row0 + ty * 4 + i) * DM + col0 + tx * 4 + j;
        Y[o] = f2bf(bf2f(GA[o]) * a1[i][j] + bf2f(GB[o]) * a2[i][j]); }
}
__global__ void __launch_bounds__(256) nv_gemm3(Ptrs P) {
    __shared__ float As[64 * 33], Bs[64 * 33];
    const int col0 = blockIdx.x * 64, row0 = blockIdx.y * 64, tid = threadIdx.x, ty = tid >> 4, tx = tid & 15;
    const bf16* Y = (const bf16*)(P.ws + WS_Y); const bf16* Wt = (const bf16*)(P.ws + WS_WOUT);
    float a1[4][4];
    nv_tile(Y, DM, Wt, DM, DM, row0, [&](int c) { return phys_of_actual(col0 + c); }, a1, As, Bs);
    for (int i = 0; i < 4; ++i) for (int j = 0; j < 4; ++j) { const size_t o = (size_t)(row0 + ty * 4 + i) * DM + col0 + tx * 4 + j; P.out[o] = P.in[0][o] + a1[i][j]; }
}

extern "C" void kernel_launch(void* const* d_in, const int* in_sizes, int n_in, void* d_out, int out_size, void* d_ws, size_t ws_size, hipStream_t stream) {
    if (ws_size < WS_END) { fprintf(stderr, "ws too small: %zu\n", ws_size); return; }
    Ptrs P{}; for (int i = 0; i < 10; ++i) P.in[i] = (const float*)d_in[i]; P.out = (float*)d_out; P.ws = (unsigned char*)d_ws;
    hipMemsetAsync((char*)d_ws + WS_CTL, 0, CTL_ZERO_BYTES, stream);
    nv_wprep<<<(DM * INW + 255) / 256, 256, 0, stream>>>(P.in[2], DM, INW, (bf16*)(P.ws + WS_WIN), DM, 0);
    nv_wprep<<<(W * DM + 255) / 256, 256, 0, stream>>>(P.in[7], W, DM, (bf16*)(P.ws + WS_WUP), DM, 0);
    nv_wprep<<<(W * DM + 255) / 256, 256, 0, stream>>>(P.in[8], W, DM, (bf16*)(P.ws + WS_WUP), DM, 512);
    nv_wprep<<<(DM * DM + 255) / 256, 256, 0, stream>>>(P.in[9], DM, DM, (bf16*)(P.ws + WS_WOUT), DM, 0);
    nv_rmsnorm<<<M / 4, 256, 0, stream>>>(P.in[0], P.in[1], (bf16*)(P.ws + WS_H));
    nv_gemm1<<<dim3(INW / 64, M / 64), 256, 0, stream>>>(P);
    nv_moba<<<M * NH / 4, 256, 0, stream>>>(P);
    nv_sb<<<M * NH / 4, 256, 0, stream>>>(P);
    nv_gemm2<<<dim3(DM / 64, M / 64), 256, 0, stream>>>(P);
    nv_gemm3<<<dim3(DM / 64, M / 64), 256, 0, stream>>>(P);
}
```

```cpp
#include <hip/hip_runtime.h>
#include <hip/hip_bf16.h>
#include <cstdio>
#include <cstdint>

namespace cfg {
constexpr int BATCH = 16, SEQ = 2048, DM = 1024, M = BATCH * SEQ;
constexpr int NH = 8, HD = 64, W = 512, INW = 6144;
constexpr int MBLK = 256, NBLK = SEQ / MBLK, TOPK = 3;
constexpr float EPS = 1e-6f;
constexpr float LOG2E = 1.4426950408889634f;
constexpr float C2 = 0.125f * LOG2E;
constexpr float SB_EXIT = 150.0f;
constexpr size_t MiB = 1u << 20;
constexpr size_t WS_CTL = 0, CTL_ZERO_BYTES = 1 * MiB, WS_KSUM = 512 * 1024;
constexpr size_t WS_WIN = 2 * MiB, WS_WUP = 14 * MiB, WS_WOUT = 16 * MiB;
constexpr size_t WS_H = 20 * MiB;
constexpr size_t WS_P = 84 * MiB;
constexpr size_t WS_GR = 340 * MiB, WS_GB = 404 * MiB;
constexpr size_t WS_Y = 84 * MiB;
constexpr size_t WS_END = 468 * MiB;
constexpr int CW_TMO = 0, CW_BAR = 4096, CW_QUEUE = 8192;
}
using namespace cfg;
#define GAS __attribute__((address_space(1)))
#define LAS __attribute__((address_space(3)))

__host__ __device__ __forceinline__ int phys_of_actual(int col) { const int a = col & 255; return (col & ~255) + 128 * ((a >> 5) & 1) + 32 * (a >> 6) + (a & 31); }
__host__ __device__ __forceinline__ int win_row_of_col(int n) { if (n < 4096) return phys_of_actual(n); const int g = n - 4096, which = g >> 10, c = g & 1023; return (16 + (c >> 7)) * 256 + 128 * which + (c & 127); }

__constant__ unsigned char T5B[128] = {0, 1, 2, 3, 4, 5, 6, 7, 8, 9, 10, 11, 12, 13, 14, 15, 16, 16, 16, 17, 17, 18, 18, 18, 19, 19, 19, 20, 20, 20, 20, 21, 21, 21, 21, 22, 22, 22, 22, 22, 23, 23, 23, 23, 23, 23, 24, 24, 24, 24, 24, 24, 25, 25, 25, 25, 25, 25, 25, 26, 26, 26, 26, 26, 26, 26, 26, 27, 27, 27, 27, 27, 27, 27, 27, 27, 27, 28, 28, 28, 28, 28, 28, 28, 28, 28, 28, 29, 29, 29, 29, 29, 29, 29, 29, 29, 29, 29, 29, 30, 30, 30, 30, 30, 30, 30, 30, 30, 30, 30, 30, 30, 30, 31, 31, 31, 31, 31, 31, 31, 31, 31, 31, 31, 31, 31, 31, 31};

namespace pg8 {
#define PG8_LAS __attribute__((address_space(3)))
typedef unsigned short bf16_t;
typedef short bf16x8 __attribute__((ext_vector_type(8)));
typedef float f32x4 __attribute__((ext_vector_type(4)));
typedef unsigned u32x4 __attribute__((ext_vector_type(4)));
constexpr int BM = 256, BK = 64, HALF = 128, HTB = HALF * BK * 2  , STAGE_BYTES = 8 * HTB, NXCD = 8, WGM = 8;

__host__ __device__ __forceinline__ int lds_byte(int r, int c) { const int st = (r >> 4) * 2 + (c >> 5), rr = r & 15, cc = c & 31, ob = rr * 64 + cc * 2; return st * 1024 + (ob ^ (((ob >> 9) & 1) << 5)); }
__host__ __device__ __forceinline__ void stage_rc(int b, int& R, int& C) { const int st = b / 1024, sb = b % 1024, swz = sb ^ (((sb >> 9) & 1) << 5); R = (st >> 1) * 16 + swz / 64; C = (st & 1) * 32 + (swz % 64) / 2; }
__host__ __device__ __forceinline__ int perm32(int rho) { const int n = rho >> 4, i = rho & 15; return 8 * (i >> 2) + 4 * n + (i & 3); }

struct Unit { int pm, pn; };
struct Gemm { const bf16_t* A; const bf16_t* Bt; int M, N, K, lda, ldb; };

struct StaticOrder {
    int nM, nN, nwg, G, c, dup;
    __host__ __device__ void init(int M, int N, int G_, int c_, int dup_ = 1) { nM = M / BM; nN = N / BM; nwg = nM * nN; G = G_; c = c_; dup = dup_; }
    __host__ __device__ bool next(int i, Unit& u) const {
        const long L = (long)(i / dup) * G + c; if (L >= nwg) return false;
        int wgid = (int)L; { const int q = nwg / NXCD, r = nwg % NXCD, xcd = wgid % NXCD, off = wgid / NXCD; wgid = (xcd < r ? xcd * (q + 1) : r * (q + 1) + (xcd - r) * q) + off; }
        const int nig = WGM * nN, gid = wgid / nig, fm = gid * WGM, gsz = (nM - fm) < WGM ? (nM - fm) : WGM;
        u.pm = fm + ((wgid % nig) % gsz); u.pn = (wgid % nig) / gsz; return true;
    }
    __device__ __forceinline__ void a_ready(const Unit&) const {}
    __device__ __forceinline__ void done(const Unit&) const {}
};


__device__ __forceinline__ unsigned cvt_pk_bf16(float lo, float hi) { unsigned r; asm volatile("v_cvt_pk_bf16_f32 %0, %1, %2" : "=v"(r) : "v"(lo), "v"(hi)); return r; }
__device__ __forceinline__ float sigm(float x) { return __builtin_amdgcn_rcpf(1.0f + __builtin_amdgcn_exp2f(-LOG2E * x)); }
__device__ __forceinline__ u32x4 pack8(const f32x4& a, const f32x4& b) { u32x4 w; w.x = cvt_pk_bf16(a[0], a[1]); w.y = cvt_pk_bf16(a[2], a[3]); w.z = cvt_pk_bf16(b[0], b[1]); w.w = cvt_pk_bf16(b[2], b[3]); return w; }
#ifndef WT_STORES
#define WT_STORES 0
#endif
#ifndef NT_STORES
#define NT_STORES 1
#endif
#ifndef NT_LOADS
#define NT_LOADS 0
#endif
__device__ __forceinline__ void st16(void* p, const u32x4& v) {
#if WT_STORES
    asm volatile("global_store_dwordx4 %0, %1, off sc1\n\ts_nop 1" :: "v"(p), "v"(v) : "memory");
#elif NT_STORES
    __builtin_nontemporal_store(v, (u32x4*)p);
#else
    *(u32x4*)p = v;
#endif
}
__device__ __forceinline__ void unpack8(const u32x4& w, f32x4& a, f32x4& b) {
    a[0] = __uint_as_float(w.x << 16); a[1] = __uint_as_float(w.x & 0xffff0000u); a[2] = __uint_as_float(w.y << 16); a[3] = __uint_as_float(w.y & 0xffff0000u);
    b[0] = __uint_as_float(w.z << 16); b[1] = __uint_as_float(w.z & 0xffff0000u); b[2] = __uint_as_float(w.w << 16); b[3] = __uint_as_float(w.w & 0xffff0000u); }

__device__ __forceinline__ void st16p(void* p, const u32x4& v) { *(u32x4*)p = v; }
#ifndef NT_QKVZ
#define NT_QKVZ 1
#endif
struct EpiProj {
    static constexpr bool PERM = true, AFTER_DRAIN = false, MIDK = false;
    unsigned char* ws; const float* gbias; const float* qnw; const float* knw; int nostore;
    __device__ __forceinline__ void mid(f32x4 (&)[2][2][4][2], const Unit&, int, int, int, int) const {}
    __device__ __forceinline__ void operator()(const f32x4 (&acc)[2][2][4][2], const Unit& u, int wr, int wc, int fr, int fq) const {
        const int pn = u.pn; const int row0 = u.pm * BM + wr * 64 + fr;
        if (pn < 16) {
            const int g = pn >> 1;
            bf16_t* base = (bf16_t*)(ws + WS_P + (size_t)g * (32 * MiB)) + (pn & 1) * 256 + wc * 64 + 8 * fq;
            if (g <= 1) {
                const float* nw = (g == 0 ? qnw : knw) + 8 * fq; f32x4 wv[2][2], cs[2][2];
#pragma unroll
                for (int bj = 0; bj < 2; ++bj)
#pragma unroll
                    for (int n = 0; n < 2; ++n) { wv[bj][n] = *(const f32x4*)(nw + 32 * bj + 4 * n); if (g == 0) wv[bj][n] = wv[bj][n] * C2; cs[bj][n] = (f32x4){0.f, 0.f, 0.f, 0.f}; }
#pragma unroll
                for (int ai = 0; ai < 2; ++ai)
#pragma unroll
                    for (int m = 0; m < 4; ++m) { float ss = 0.f;
#pragma unroll
                        for (int bj = 0; bj < 2; ++bj)
#pragma unroll
                            for (int n = 0; n < 2; ++n) { const f32x4 x = acc[ai][bj][m][n]; ss += (x[0] * x[0] + x[1] * x[1]) + (x[2] * x[2] + x[3] * x[3]); }
                        ss += __shfl_xor(ss, 16); ss += __shfl_xor(ss, 32);
                        const float rstd = __builtin_amdgcn_rsqf(ss * (1.0f / 64.0f) + EPS);
                        bf16_t* rowp = base + (size_t)(row0 + ai * HALF + m * 16) * W;
#pragma unroll
                        for (int bj = 0; bj < 2; ++bj) { const f32x4 v0 = acc[ai][bj][m][0] * rstd * wv[bj][0], v1 = acc[ai][bj][m][1] * rstd * wv[bj][1];
                            if (g == 1) { cs[bj][0] += v0; cs[bj][1] += v1; }
                            if (!nostore) { if (NT_QKVZ) st16(rowp + bj * 32, pack8(v0, v1)); else st16p(rowp + bj * 32, pack8(v0, v1)); } } }
                if (g == 1) {
                    float* ks = (float*)(ws + WS_KSUM) + ((size_t)((u.pm >> 3) * NH + (pn & 1) * 4 + wc) * NBLK + (u.pm & 7)) * 64 + 8 * fq;
#pragma unroll
                    for (int bj = 0; bj < 2; ++bj)
#pragma unroll
                        for (int n = 0; n < 2; ++n)
#pragma unroll
                            for (int e = 0; e < 4; ++e) { float x = cs[bj][n][e]; x += __shfl_xor(x, 1); x += __shfl_xor(x, 2); x += __shfl_xor(x, 4); x += __shfl_xor(x, 8);
                                if (fr == 0 && !nostore) atomicAdd(ks + 32 * bj + 4 * n + e, x); }
                }
            } else {
                const bool silu = (g == 3) || (g == 7); const float sc = (g == 4) ? C2 : 1.0f;
#pragma unroll
                for (int ai = 0; ai < 2; ++ai)
#pragma unroll
                    for (int m = 0; m < 4; ++m) { bf16_t* rowp = base + (size_t)(row0 + ai * HALF + m * 16) * W;
#pragma unroll
                        for (int bj = 0; bj < 2; ++bj) { f32x4 v0 = acc[ai][bj][m][0] * sc, v1 = acc[ai][bj][m][1] * sc;
                            if (silu) {
#pragma unroll
                                for (int e = 0; e < 4; ++e) { v0[e] = v0[e] * sigm(v0[e]); v1[e] = v1[e] * sigm(v1[e]); } }
                            if (!nostore) { if (NT_QKVZ) st16(rowp + bj * 32, pack8(v0, v1)); else st16p(rowp + bj * 32, pack8(v0, v1)); } } }
            }
        } else {
            const int gc = 128 * (pn - 16) + 32 * wc + 8 * fq; f32x4 ba[2], bb[2];
#pragma unroll
            for (int n = 0; n < 2; ++n) { ba[n] = *(const f32x4*)(gbias + gc + 4 * n); bb[n] = *(const f32x4*)(gbias + DM + gc + 4 * n); }
            bf16_t* gr = (bf16_t*)(ws + WS_GR) + gc; bf16_t* gbp = (bf16_t*)(ws + WS_GB) + gc;
#pragma unroll
            for (int ai = 0; ai < 2; ++ai)
#pragma unroll
                for (int m = 0; m < 4; ++m) { const size_t ro = (size_t)(row0 + ai * HALF + m * 16) * DM; f32x4 r[2], b[2];
#pragma unroll
                    for (int n = 0; n < 2; ++n)
#pragma unroll
                        for (int e = 0; e < 4; ++e) { const float sa = sigm(acc[ai][0][m][n][e] + ba[n][e]); const float sb = __builtin_fmaxf(sigm(acc[ai][1][m][n][e] + bb[n][e]), 9.5367431640625e-07f);
                            b[n][e] = sb; r[n][e] = sa * __builtin_amdgcn_rcpf(sb); }
                    if (!nostore) { st16(gr + ro, pack8(r[0], r[1])); st16(gbp + ro, pack8(b[0], b[1])); } }
        }
    }
};
struct EpiY {
    static constexpr bool PERM = true, AFTER_DRAIN = false, MIDK = true;
    const bf16_t* GR; const bf16_t* GB; bf16_t* Y;
    __device__ __forceinline__ void mid(f32x4 (&acc)[2][2][4][2], const Unit& u, int wr, int wc, int fr, int fq) const {
        unsigned lo = (unsigned)(fr * DM + 8 * fq); asm volatile("" : "+v"(lo));
        const bf16_t* p = GR + (size_t)(u.pm * BM + wr * 64) * DM + u.pn * BM + wc * 64 + lo;
#pragma unroll
        for (int ai = 0; ai < 2; ++ai)
#pragma unroll
            for (int m = 0; m < 4; ++m) {
#pragma unroll
                for (int bj = 0; bj < 2; ++bj) { const u32x4 w = NT_LOADS ? __builtin_nontemporal_load((const u32x4*)(p + (size_t)(ai * HALF + m * 16) * DM + bj * 32)) : *(const u32x4*)(p + (size_t)(ai * HALF + m * 16) * DM + bj * 32); f32x4 a, b; unpack8(w, a, b);
                    acc[ai][bj][m][0] = acc[ai][bj][m][0] * a; acc[ai][bj][m][1] = acc[ai][bj][m][1] * b; }
                asm volatile("" ::: "memory"); }
    }
    __device__ __forceinline__ void operator()(const f32x4 (&acc)[2][2][4][2], const Unit& u, int wr, int wc, int fr, int fq) const {
        unsigned lo = (unsigned)(fr * DM + 8 * fq); asm volatile("" : "+v"(lo));
        const size_t o0 = (size_t)(u.pm * BM + wr * 64) * DM + u.pn * BM + wc * 64 + lo;
#pragma unroll
        for (int ai = 0; ai < 2; ++ai)
#pragma unroll
            for (int m = 0; m < 4; ++m) {
#pragma unroll
                for (int bj = 0; bj < 2; ++bj) { const size_t o = o0 + (size_t)(ai * HALF + m * 16) * DM + bj * 32; const u32x4 w = NT_LOADS ? __builtin_nontemporal_load((const u32x4*)(GB + o)) : *(const u32x4*)(GB + o); f32x4 a, b; unpack8(w, a, b);
                    st16(Y + o, pack8(acc[ai][bj][m][0] * a, acc[ai][bj][m][1] * b)); }
                if (m == 3) asm volatile("" ::: "memory"); }
    }
};
struct EpiOut {
    static constexpr bool PERM = true, AFTER_DRAIN = false, MIDK = false;
    const float* X; float* OUT;
    __device__ __forceinline__ void mid(f32x4 (&)[2][2][4][2], const Unit&, int, int, int, int) const {}
    __device__ __forceinline__ void operator()(const f32x4 (&acc)[2][2][4][2], const Unit& u, int wr, int wc, int fr, int fq) const {
        const size_t o0 = (size_t)(u.pm * BM + wr * 64 + fr) * DM + u.pn * BM + wc * 64 + 8 * fq;
#pragma unroll
        for (int ai = 0; ai < 2; ++ai)
#pragma unroll
            for (int m = 0; m < 4; ++m) {
#pragma unroll
                for (int bj = 0; bj < 2; ++bj) { const size_t o = o0 + (size_t)(ai * HALF + m * 16) * DM + bj * 32;
                    const f32x4 x0 = NT_LOADS ? __builtin_nontemporal_load((const f32x4*)(X + o)) : *(const f32x4*)(X + o), x1 = NT_LOADS ? __builtin_nontemporal_load((const f32x4*)(X + o + 4)) : *(const f32x4*)(X + o + 4);

#ifdef NT_OUT
                    __builtin_nontemporal_store(x0 + acc[ai][bj][m][0], (f32x4*)(OUT + o)); __builtin_nontemporal_store(x1 + acc[ai][bj][m][1], (f32x4*)(OUT + o + 4)); }
#else
                    *(f32x4*)(OUT + o) = x0 + acc[ai][bj][m][0]; *(f32x4*)(OUT + o + 4) = x1 + acc[ai][bj][m][1]; }
#endif

                if (m == 3) asm volatile("" ::: "memory"); }
    }
};

template <class Epi, class Sched, bool ALIGN_EPI = false, bool SP2 = false>
__device__ __forceinline__ void gemm_phase(PG8_LAS unsigned char* lds, const Gemm g, const Sched& S, const Epi& E) {
    const int tid = threadIdx.x, wid = __builtin_amdgcn_readfirstlane(tid >> 6), lane = tid & 63, wr = wid >> 2, wc = wid & 3, fr = lane & 15, fq = lane >> 4;
    const int K = g.K, nt = K / BK;
    unsigned voffA[2], voffB[2];
#pragma unroll
    for (int i = 0; i < 2; ++i) { int R, C; stage_rc(tid * 16 + i * 8192, R, C); const int Rb = Epi::PERM ? ((R & ~31) + perm32(R & 31)) : R;
        voffA[i] = (unsigned)(R * g.lda + C) * 2u; voffB[i] = (unsigned)(Rb * g.ldb + C) * 2u; }
    const size_t kstep = (size_t)(BK * 2);
    const size_t hA = (size_t)HALF * g.lda * 2, hB = (size_t)HALF * g.ldb * 2;
    const size_t tA = 2 * hA, tB = 2 * hB;
    const unsigned ldsw = (unsigned)wid * 1024u;
    const int aoff = lds_byte(wr * 64 + fr, fq * 8), boff = lds_byte(wc * 32 + fr, fq * 8);
#define PG8_SA(b, h) (((b) * 2 + (h)) * HTB)
#define PG8_SB(b, h) ((4 + (b) * 2 + (h)) * HTB)
#define PG8_STAGE(bufoff, gbase, voff) do { _Pragma("unroll") for (int _i = 0; _i < 2; ++_i) \
        __builtin_amdgcn_global_load_lds((const unsigned*)((const char*)(gbase) + (voff)[_i]), (PG8_LAS unsigned*)(lds + (bufoff) + ldsw + _i * 8192), 16, 0, 0); } while (0)
#define PG8_LDA(dst, b, h) do { _Pragma("unroll") for (int m = 0; m < 4; ++m) _Pragma("unroll") for (int k = 0; k < 2; ++k) dst[m][k] = *(const PG8_LAS bf16x8*)(lds + PG8_SA(b, h) + aoff + m * 2048 + k * 1024); } while (0)
#define PG8_LDB(dst, b, h) do { _Pragma("unroll") for (int n = 0; n < 2; ++n) _Pragma("unroll") for (int k = 0; k < 2; ++k) dst[n][k] = *(const PG8_LAS bf16x8*)(lds + PG8_SB(b, h) + boff + n * 2048 + k * 1024); } while (0)
#define PG8_MMA(ai, bj, At, Bt) do { __builtin_amdgcn_s_setprio(1); _Pragma("unroll") for (int m = 0; m < 4; ++m) _Pragma("unroll") for (int n = 0; n < 2; ++n) _Pragma("unroll") for (int k = 0; k < 2; ++k) \
        acc[ai][bj][m][n] = __builtin_amdgcn_mfma_f32_16x16x32_bf16(Bt[n][k], At[m][k], acc[ai][bj][m][n], 0, 0, 0); __builtin_amdgcn_s_setprio(0); } while (0)
#define PG8_WAIT_V(n) asm volatile("s_waitcnt vmcnt(" #n ")" ::: "memory")
#define PG8_WAIT_L(n) asm volatile("s_waitcnt lgkmcnt(" #n ")" ::: "memory")
#define PG8_BAR __builtin_amdgcn_s_barrier()
#define PG8_SCHED __builtin_amdgcn_sched_barrier(0)
    Unit cur, nxt; int ui = 0;
    if (!S.next(0, cur)) return;
    f32x4 acc[2][2][4][2];
#pragma unroll
    for (int a = 0; a < 2; ++a)
#pragma unroll
        for (int b = 0; b < 2; ++b)
#pragma unroll
            for (int m = 0; m < 4; ++m)
#pragma unroll
                for (int n = 0; n < 2; ++n) acc[a][b][m][n] = (f32x4){0.f, 0.f, 0.f, 0.f};
    bf16x8 At[4][2], B0[2][2], B1[2][2];
    const char* cA = (const char*)g.A + (size_t)cur.pm * tA; const char* cB = (const char*)g.Bt + (size_t)cur.pn * tB;
    S.a_ready(cur);
    if constexpr (SP2) {
        PG8_STAGE(PG8_SB(0, 0), cB, voffB); PG8_STAGE(PG8_SB(0, 1), cB + hB, voffB); PG8_STAGE(PG8_SA(0, 0), cA, voffA); PG8_STAGE(PG8_SA(0, 1), cA + hA, voffA);
        if (wr == 1) PG8_BAR;
        PG8_WAIT_V(2); PG8_BAR;
        PG8_STAGE(PG8_SB(1, 0), cB + kstep, voffB); PG8_STAGE(PG8_SA(1, 0), cA + kstep, voffA); PG8_STAGE(PG8_SB(1, 1), cB + hB + kstep, voffB);
        PG8_WAIT_V(6); PG8_BAR;
    } else {
        PG8_STAGE(PG8_SB(0, 0), cB, voffB); PG8_STAGE(PG8_SA(0, 0), cA, voffA); PG8_STAGE(PG8_SB(0, 1), cB + hB, voffB); PG8_STAGE(PG8_SA(0, 1), cA + hA, voffA);
        if (wr == 1) PG8_BAR;
        PG8_WAIT_V(4); PG8_BAR;
        PG8_STAGE(PG8_SB(1, 0), cB + kstep, voffB); PG8_STAGE(PG8_SA(1, 0), cA + kstep, voffA); PG8_STAGE(PG8_SB(1, 1), cB + hB + kstep, voffB);
        PG8_WAIT_V(6); PG8_BAR;
    }
    for (;;) {
        const bool has_next = S.next(ui + 1, nxt);
        const char* nA = has_next ? (const char*)g.A + (size_t)nxt.pm * tA : cA; const char* nB = has_next ? (const char*)g.Bt + (size_t)nxt.pn * tB : cB;
        constexpr int NH = Epi::MIDK ? 2 : 1;
#pragma unroll 1
        for (int hh = 0; hh < NH; ++hh) {
        if constexpr (Epi::MIDK) { if (hh == 1) { int fr_ = fr, fq_ = fq; asm volatile("" : "+v"(fr_), "+v"(fq_)); E.mid(acc, cur, wr, wc, fr_, fq_); } }
#pragma unroll 1
        for (int t = hh * (nt / NH); t < (hh + 1) * (nt / NH); t += 2) {
            const bool last = (t == nt - 2);
            const char* a1 = cA + (size_t)(t + 1) * kstep;
            const char* a2 = last ? nA : cA + (size_t)(t + 2) * kstep; const char* b2 = last ? nB : cB + (size_t)(t + 2) * kstep;
            const char* a3 = a2 + kstep; const char* b3 = b2 + kstep;
            if (last && has_next) S.a_ready(nxt);
            if constexpr (SP2) {
            PG8_LDB(B0, 0, 0); PG8_LDB(B1, 0, 1); PG8_SCHED; PG8_LDA(At, 0, 0); PG8_STAGE(PG8_SA(1, 1), a1 + hA, voffA);
            PG8_WAIT_V(8); PG8_WAIT_L(0); PG8_BAR; PG8_MMA(0, 0, At, B0); PG8_MMA(0, 1, At, B1); PG8_BAR; PG8_SCHED;
            PG8_LDA(At, 0, 1); PG8_STAGE(PG8_SB(0, 0), b2, voffB); PG8_STAGE(PG8_SB(0, 1), b2 + hB, voffB); PG8_STAGE(PG8_SA(0, 0), a2, voffA);
            PG8_WAIT_V(8); PG8_WAIT_L(0); PG8_BAR; PG8_MMA(1, 0, At, B0); PG8_MMA(1, 1, At, B1); PG8_BAR; PG8_SCHED;
            PG8_LDB(B0, 1, 0); PG8_LDB(B1, 1, 1); PG8_SCHED; PG8_LDA(At, 1, 0); PG8_STAGE(PG8_SA(0, 1), a2 + hA, voffA);
            PG8_WAIT_V(8); PG8_WAIT_L(0); PG8_BAR; PG8_MMA(0, 0, At, B0); PG8_MMA(0, 1, At, B1); PG8_BAR; PG8_SCHED;
            PG8_LDA(At, 1, 1); PG8_STAGE(PG8_SB(1, 0), b3, voffB); PG8_STAGE(PG8_SB(1, 1), b3 + hB, voffB); PG8_STAGE(PG8_SA(1, 0), a3, voffA);
            PG8_WAIT_V(8); PG8_WAIT_L(0); PG8_BAR; PG8_MMA(1, 0, At, B0); PG8_MMA(1, 1, At, B1); PG8_BAR; PG8_SCHED;
            } else {
            PG8_LDB(B0, 0, 0); PG8_SCHED; PG8_LDA(At, 0, 0); PG8_STAGE(PG8_SA(1, 1), a1 + hA, voffA);
            PG8_WAIT_L(8); PG8_BAR; PG8_WAIT_L(0); PG8_MMA(0, 0, At, B0); PG8_BAR; PG8_SCHED;
            PG8_LDB(B1, 0, 1); PG8_STAGE(PG8_SB(0, 0), b2, voffB);
            PG8_BAR; PG8_WAIT_L(0); PG8_MMA(0, 1, At, B1); PG8_BAR;
            PG8_LDA(At, 0, 1); PG8_STAGE(PG8_SA(0, 0), a2, voffA);
            PG8_BAR; PG8_WAIT_L(0); PG8_MMA(1, 0, At, B0); PG8_BAR; PG8_SCHED;
            PG8_STAGE(PG8_SB(0, 1), b2 + hB, voffB);
            PG8_WAIT_V(6); PG8_BAR; PG8_MMA(1, 1, At, B1); PG8_BAR;
            PG8_LDB(B0, 1, 0); PG8_SCHED; PG8_LDA(At, 1, 0); PG8_STAGE(PG8_SA(0, 1), a2 + hA, voffA);
            PG8_WAIT_L(8); PG8_BAR; PG8_WAIT_L(0); PG8_MMA(0, 0, At, B0); PG8_BAR; PG8_SCHED;
            PG8_LDB(B1, 1, 1); PG8_STAGE(PG8_SB(1, 0), b3, voffB);
            PG8_BAR; PG8_WAIT_L(0); PG8_MMA(0, 1, At, B1); PG8_BAR;
            PG8_LDA(At, 1, 1); PG8_STAGE(PG8_SA(1, 0), a3, voffA);
            PG8_BAR; PG8_WAIT_L(0); PG8_MMA(1, 0, At, B0); PG8_BAR; PG8_SCHED;
            PG8_STAGE(PG8_SB(1, 1), b3 + hB, voffB);
            PG8_WAIT_V(6); PG8_BAR; PG8_MMA(1, 1, At, B1); PG8_BAR;
            }
        }
        }
        if constexpr (ALIGN_EPI) { if (wr == 0) PG8_BAR; }
        if constexpr (!Epi::AFTER_DRAIN) { int fr_ = fr, fq_ = fq; asm volatile("" : "+v"(fr_), "+v"(fq_));
            E(acc, cur, wr, wc, fr_, fq_);
#ifdef EPI2
            asm volatile("" : "+v"(fr_), "+v"(fq_)); E(acc, cur, wr, wc, fr_, fq_);
#endif
            S.done(cur); }
        if (!has_next) break;
#pragma unroll
        for (int a = 0; a < 2; ++a)
#pragma unroll
            for (int b = 0; b < 2; ++b)
#pragma unroll
                for (int m = 0; m < 4; ++m)
#pragma unroll
                    for (int n = 0; n < 2; ++n) acc[a][b][m][n] = (f32x4){0.f, 0.f, 0.f, 0.f};
        cur = nxt; cA = nA; cB = nB; ++ui;
        if constexpr (ALIGN_EPI) { if (wr == 1) PG8_BAR; }
    }
    PG8_WAIT_V(0);
    if constexpr (!ALIGN_EPI) { if (wr == 0) PG8_BAR; }
    PG8_BAR;
    if constexpr (Epi::AFTER_DRAIN) { E.fused(acc, cur, wr, wc, fr, fq, lds, wid, lane); S.done(cur); }
#undef PG8_SA
#undef PG8_SB
#undef PG8_STAGE
#undef PG8_LDA
#undef PG8_LDB
#undef PG8_MMA
#undef PG8_WAIT_V
#undef PG8_WAIT_L
#undef PG8_BAR
#undef PG8_SCHED
}
}

#ifndef PG8_SP2
#define PG8_SP2 true
#endif
#ifndef PG8_ALIGN
#define PG8_ALIGN true
#endif

namespace attn {
using bf16 = unsigned short;
using bf16x8 = __attribute__((ext_vector_type(8))) short;
using f16x8 = __attribute__((ext_vector_type(8))) _Float16;
using s16x4 = __attribute__((ext_vector_type(4))) short;
using f32x16 = __attribute__((ext_vector_type(16))) float;
using f32x4 = __attribute__((ext_vector_type(4))) float;
using u32x4 = __attribute__((ext_vector_type(4))) unsigned;
typedef LAS const char* lds_cptr;
constexpr int NW = 8, QBLK = 32, QB = 256, KVBLK = 64, PITCH = W, OPITCH = DM;
constexpr int SLOTB = 8192;
constexpr int NSLOT = 3;
constexpr int LDS_K = 0, LDS_V = NSLOT * SLOTB, LDS_WS = 2 * NSLOT * SLOTB, LDS_TAB = LDS_WS + NW * 256, LDS_FLAG = LDS_TAB + 1024, LDS_OST = LDS_FLAG + 1024, LDS_ZST = LDS_OST + NW * 4096, LDS_BYTES = LDS_ZST + NW * 4096;
__device__ __forceinline__ int crow(int r, int hi) { return (r & 3) + 8 * (r >> 2) + 4 * hi; }
#define SBAR() __builtin_amdgcn_sched_barrier(0)
#ifdef UT_PROBE
#ifndef UT_UNIT
#define UT_UNIT 0
#endif
#define UTS(k) do { if (blockIdx.x == 0 && threadIdx.x == 0) { volatile LAS unsigned long long* u_ = (volatile LAS unsigned long long*)(shm + 132096); if (u_[7] == (unsigned long long)UT_UNIT) u_[k] = __builtin_amdgcn_s_memrealtime(); if ((k) == 4) u_[7] = u_[7] + 1ull; } } while (0)
#else
#define UTS(k) do {} while (0)
#endif
#define WAIT_BAR0() asm volatile("s_waitcnt vmcnt(0) lgkmcnt(0)\n\ts_barrier" ::: "memory")
__device__ __forceinline__ void glds16(const void* gsrc, unsigned lds_dst) { unsigned keep;
    asm volatile("s_mov_b32 %0, m0\n\ts_mov_b32 m0, %2\n\ts_nop 0\n\tglobal_load_lds_dwordx4 %1, off\n\ts_mov_b32 m0, %0" : "=&s"(keep) : "v"(gsrc), "s"(lds_dst) : "memory"); }
__device__ __forceinline__ unsigned cvtpk(float lo, float hi) { typedef float f2 __attribute__((ext_vector_type(2))); typedef __bf16 b2 __attribute__((ext_vector_type(2))); f2 v = {lo, hi}; b2 b = __builtin_convertvector(v, b2); return __builtin_bit_cast(unsigned, b); }
__device__ __forceinline__ unsigned cvtpk_h(float lo, float hi) { typedef float f2 __attribute__((ext_vector_type(2))); typedef _Float16 h2 __attribute__((ext_vector_type(2))); f2 v = {lo, hi}; h2 b = __builtin_convertvector(v, h2); return __builtin_bit_cast(unsigned, b); }
#define MX3(a, b, c) __builtin_fmaxf(__builtin_fmaxf((a), (b)), (c))
__device__ __forceinline__ float rowmax(const f32x16& p0, const f32x16& p1) {
    float a = MX3(p0[0], p0[1], p1[0]), b = MX3(p0[2], p0[3], p1[1]); a = MX3(a, p1[2], p1[3]);
#pragma unroll
    for (int r = 4; r < 16; r += 4) { a = MX3(a, p0[r], p0[r + 1]); b = MX3(b, p0[r + 2], p0[r + 3]); a = MX3(a, p1[r], p1[r + 1]); b = MX3(b, p1[r + 2], p1[r + 3]); }
    float m = __builtin_fmaxf(a, b); auto rr = __builtin_amdgcn_permlane32_swap(__float_as_uint(m), __float_as_uint(m), false, false);
    return __builtin_fmaxf(__uint_as_float(rr[0]), __uint_as_float(rr[1])); }
__device__ __forceinline__ float lowhalf(float v) { auto rr = __builtin_amdgcn_permlane32_swap(__float_as_uint(v), __float_as_uint(v), false, false); return __uint_as_float(rr[0]); }
__device__ __forceinline__ float fadd_s(float a, float b) { float r; asm("v_add_f32_e32 %0, %1, %2" : "=v"(r) : "v"(a), "v"(b)); return r; }
__device__ __forceinline__ float fsub_s(float a, float b) { float r; asm("v_sub_f32_e32 %0, %1, %2" : "=v"(r) : "v"(a), "v"(b)); return r; }
__device__ __forceinline__ unsigned cvtpk_s(float lo, float hi) { return cvtpk(lo, hi); }
typedef short v4i16_t __attribute__((ext_vector_type(4)));
__device__ __forceinline__ void kload8(bf16x8* kf, lds_cptr kp) {
    kf[0] = *(const LAS bf16x8*)(kp);        kf[1] = *(const LAS bf16x8*)(kp + 512);
    kf[2] = *(const LAS bf16x8*)(kp + 2048); kf[3] = *(const LAS bf16x8*)(kp + 2560);
    kf[4] = *(const LAS bf16x8*)(kp + 4096); kf[5] = *(const LAS bf16x8*)(kp + 4608);
    kf[6] = *(const LAS bf16x8*)(kp + 6144); kf[7] = *(const LAS bf16x8*)(kp + 6656); }
__device__ __forceinline__ void kload2(bf16x8* kf, lds_cptr kp, int j) { kf[2 * j] = *(const LAS bf16x8*)(kp + j * 2048); kf[2 * j + 1] = *(const LAS bf16x8*)(kp + j * 2048 + 512); }
__device__ __forceinline__ s16x4 vtr(lds_cptr p) { return __builtin_bit_cast(s16x4, __builtin_amdgcn_ds_read_tr16_b64_v4i16((LAS v4i16_t*)p)); }
__device__ __forceinline__ void qkt(f32x16& p0, f32x16& p1, lds_cptr Kslot, const bf16x8* qr, const f32x16& c0, int r32, int hi) {
    const lds_cptr kb = Kslot + hi * 1024 + r32 * 16;
#pragma unroll
    for (int d0 = 0; d0 < 4; ++d0) {
        const bf16x8 b0 = *(const LAS bf16x8*)(kb + d0 * 2048);
        const bf16x8 b1 = *(const LAS bf16x8*)(kb + d0 * 2048 + 512);
        if (d0 == 0) { p0 = __builtin_amdgcn_mfma_f32_32x32x16_bf16(b0, qr[0], c0, 0, 0, 0); p1 = __builtin_amdgcn_mfma_f32_32x32x16_bf16(b1, qr[0], c0, 0, 0, 0); }
        else { p0 = __builtin_amdgcn_mfma_f32_32x32x16_bf16(b0, qr[d0], p0, 0, 0, 0); p1 = __builtin_amdgcn_mfma_f32_32x32x16_bf16(b1, qr[d0], p1, 0, 0, 0); } }
}
__device__ __forceinline__ void pv(f32x16* o, int vb, bf16x8 pa0, bf16x8 pa1, bf16x8 pa2, bf16x8 pa3) {
#pragma unroll
    for (int d0 = 0; d0 < 2; ++d0) { s16x4 lo[4], hi[4];
#pragma unroll
        for (int ks = 0; ks < 4; ++ks) {
            asm volatile("ds_read_b64_tr_b16 %0,%1 offset:%c2" : "=&v"(lo[ks]) : "v"(vb), "i"(d0 * 4096 + ks * 1024) : "memory");
            asm volatile("ds_read_b64_tr_b16 %0,%1 offset:%c2" : "=&v"(hi[ks]) : "v"(vb), "i"(d0 * 4096 + ks * 1024 + 512) : "memory"); }
        asm volatile("s_waitcnt lgkmcnt(0)" ::: "memory"); SBAR();
#define PK(k) (bf16x8){lo[k][0], lo[k][1], lo[k][2], lo[k][3], hi[k][0], hi[k][1], hi[k][2], hi[k][3]}
        o[d0] = __builtin_amdgcn_mfma_f32_32x32x16_bf16(pa0, PK(0), o[d0], 0, 0, 0);
        o[d0] = __builtin_amdgcn_mfma_f32_32x32x16_bf16(pa1, PK(1), o[d0], 0, 0, 0);
        o[d0] = __builtin_amdgcn_mfma_f32_32x32x16_bf16(pa2, PK(2), o[d0], 0, 0, 0);
        o[d0] = __builtin_amdgcn_mfma_f32_32x32x16_bf16(pa3, PK(3), o[d0], 0, 0, 0);
#undef PK
    }
}
#define PKW(P, B) cvtpk(P[B], P[B + 1])
__device__ __forceinline__ void store_gated(const f32x16* o, const float* rsc  , LAS char* stage, const u32x4* zr  , bf16* Ow, int lane, int r32, int hi) {
    LAS bf16* stg = (LAS bf16*)stage;
#pragma unroll
    for (int r = 0; r < 16; ++r) { const int orow = crow(r, hi); const float s = rsc ? rsc[r] : 1.0f;
#pragma unroll
        for (int d0 = 0; d0 < 2; ++d0) { const float v = o[d0][r] * s; const unsigned u = cvtpk(v, v); stg[orow * 64 + d0 * 32 + r32] = (bf16)(u & 0xffffu); } }
    asm volatile("s_waitcnt lgkmcnt(0)" ::: "memory");
#pragma unroll
    for (int i = 0; i < 4; ++i) { const int row = i * 8 + (lane >> 3), ch = lane & 7; const u32x4 v = *(const LAS u32x4*)(stg + row * 64 + ch * 8); const u32x4 z = zr[i];
        u32x4 w;
#pragma unroll
        for (int k = 0; k < 4; ++k) { const float a0 = __uint_as_float(v[k] << 16) * __uint_as_float(z[k] << 16), a1 = __uint_as_float(v[k] & 0xffff0000u) * __uint_as_float(z[k] & 0xffff0000u); w[k] = cvtpk(a0, a1); }
        __builtin_nontemporal_store(w, (u32x4*)(Ow + (size_t)row * OPITCH + ch * 8)); }
}

__device__ __forceinline__ void moba_tables(LAS float* tabs, const float* rel_bias  , int tid) {
    for (int e = tid; e < NH * 130; e += NW * 64) { const int hh = e / 130, i = e % 130; tabs[hh * 132 + i] = (i == 0) ? -1e30f : (i < 129 ? (rel_bias[hh * 32 + T5B[i - 1]] - rel_bias[hh * 32 + 31]) * LOG2E : 0.f); }
}
__device__ __forceinline__ unsigned moba_select(const float* ksum, const bf16x8* qr, int qb, int r32, int hi) {
    unsigned selmask = 0u;
        f32x16 g = f32x16{};
#pragma unroll
        for (int d0 = 0; d0 < 4; ++d0) { const float* kp = ksum + (r32 & 7) * 64 + d0 * 16 + hi * 8; f32x4 x0 = *(const f32x4*)kp, x1 = *(const f32x4*)(kp + 4);
            if (r32 >= 8) { x0 = (f32x4){0.f, 0.f, 0.f, 0.f}; x1 = x0; }
            u32x4 wh, wl; f32x4 y0, y1;
            wh.x = cvtpk(x0[0], x0[1]); wh.y = cvtpk(x0[2], x0[3]); wh.z = cvtpk(x1[0], x1[1]); wh.w = cvtpk(x1[2], x1[3]);
            y0[0] = x0[0] - __uint_as_float(wh.x << 16); y0[1] = x0[1] - __uint_as_float(wh.x & 0xffff0000u); y0[2] = x0[2] - __uint_as_float(wh.y << 16); y0[3] = x0[3] - __uint_as_float(wh.y & 0xffff0000u);
            y1[0] = x1[0] - __uint_as_float(wh.z << 16); y1[1] = x1[1] - __uint_as_float(wh.z & 0xffff0000u); y1[2] = x1[2] - __uint_as_float(wh.w << 16); y1[3] = x1[3] - __uint_as_float(wh.w & 0xffff0000u);
            wl.x = cvtpk(y0[0], y0[1]); wl.y = cvtpk(y0[2], y0[3]); wl.z = cvtpk(y1[0], y1[1]); wl.w = cvtpk(y1[2], y1[3]);
            g = __builtin_amdgcn_mfma_f32_32x32x16_bf16(__builtin_bit_cast(bf16x8, wh), qr[d0], g, 0, 0, 0);
            g = __builtin_amdgcn_mfma_f32_32x32x16_bf16(__builtin_bit_cast(bf16x8, wl), qr[d0], g, 0, 0, 0); }
        float G[8];
#pragma unroll
        for (int r = 0; r < 4; ++r) { auto rr = __builtin_amdgcn_permlane32_swap(__float_as_uint(g[r]), __float_as_uint(g[r]), false, false); G[r] = __uint_as_float(rr[0]); G[4 + r] = __uint_as_float(rr[1]); }
#pragma unroll
        for (int n = 0; n < 8; ++n) { int cnt = 0;
#pragma unroll
            for (int m = 0; m < 8; ++m) cnt += (m < qb) && ((G[m] > G[n]) || (G[m] == G[n] && m < n));
            if (n < qb && cnt < TOPK) selmask |= 1u << n; }
    return selmask;
}

__device__ __forceinline__ void load_gate(u32x4* zr, const bf16* Zw, int lane) {
#pragma unroll
    for (int i = 0; i < 4; ++i) zr[i] = *(const u32x4*)(Zw + (size_t)(i * 8 + (lane >> 3)) * PITCH + (lane & 7) * 8);
}
__device__ __forceinline__ void warm_rows(const bf16* base  , long row0, int ninstr, unsigned dummy_lds, int wid, int lane) {
    const bf16* p = base + (row0 + (long)wid * 8 * ninstr + (lane >> 3)) * PITCH + (lane & 7) * 8;
    for (int i = 0; i < ninstr; ++i) glds16(p + (long)(8 * i) * PITCH, dummy_lds);
}
template <int THRL>
__device__ __forceinline__ void moba_unit(int b, int h, int qb, const bf16* Q, const bf16* __restrict__ K, const bf16* __restrict__ V, const bf16* Z, bf16* O, const float* ksum, const float* relb, LAS char* lds) {
    int tid_ = threadIdx.x; asm volatile("" : "+v"(tid_));
    const int tid = tid_, lane = tid & 63, r32 = lane & 31, hi = lane >> 5; const int wid = __builtin_amdgcn_readfirstlane(tid >> 6);
    const long rowbase = (long)b * SEQ; const int q0 = qb * QB, wq0 = q0 + wid * QBLK;
    const bf16* Qw = Q + (rowbase + wq0) * PITCH + h * HD;
    const bf16* Kh = K + rowbase * PITCH + h * HD; const bf16* Vh = V + rowbase * PITCH + h * HD;
    const unsigned lds0 = (unsigned)(uintptr_t)lds;
    LAS float* wsf = (LAS float*)(lds + LDS_WS) + wid * 64; LAS float* tab = (LAS float*)(lds + LDS_TAB);
    const bf16* ksrc = Kh + (long)lane * PITCH + wid * 8;
    const bf16* vsrc = Vh + (long)(16 * (wid & 3) + (lane >> 2)) * PITCH + (wid >> 2) * 32 + (lane & 3) * 8;
    const unsigned kdst = lds0 + LDS_K + wid * 1024, vdst = lds0 + LDS_V + wid * 1024;
#define DMA_K(t, slot) glds16(ksrc + (long)(t) * KVBLK * PITCH, (unsigned)__builtin_amdgcn_readfirstlane(kdst + (slot)))
#define DMA_V(t, slot) glds16(vsrc + (long)(t) * KVBLK * PITCH, (unsigned)__builtin_amdgcn_readfirstlane(vdst + (slot)))
    const int vb0 = (int)(lds0 + LDS_V) + ((lane >> 4) & 1) * 32 + (lane & 3) * 8 + (4 * hi + ((lane & 15) >> 2)) * 64;
    const lds_cptr Kbase = (lds_cptr)lds + LDS_K;
    if (tid <= 128) tab[tid] = tid < 128 ? (relb[T5B[tid]] - relb[31]) * LOG2E : 0.f;
    DMA_K(0, 0); DMA_V(0, 0);
    bf16x8 qr[4];
#pragma unroll
    for (int d0 = 0; d0 < 4; ++d0) qr[d0] = *reinterpret_cast<const bf16x8*>(&Qw[(long)r32 * PITCH + d0 * 16 + hi * 8]);
    const unsigned selmask = (qb <= TOPK) ? ((1u << qb) - 1u) : moba_select(ksum, qr, qb, r32, hi);
    float mhat = 0.f, l_reg = 0.f; bool set = false; f32x16 o[2]; o[0] = f32x16{}; o[1] = f32x16{};
    const int NT = (q0 + QB) / KVBLK;
    for (int t = 0; t < NT; ++t) {
        const int slot = (t & 1) * SLOTB;
        WAIT_BAR0();
        if (t + 1 < NT) { DMA_K(t + 1, slot ^ SLOTB); DMA_V(t + 1, slot ^ SLOTB); }
        const int key0 = t * KVBLK;
        if (key0 > wq0 + QBLK - 1) continue;
        const int blk = t >> 2; const bool on = (blk == qb) || ((selmask >> blk) & 1u);
        const float nm = on ? -mhat : -1e30f; f32x16 negm;
#pragma unroll
        for (int r = 0; r < 16; ++r) negm[r] = nm;
        f32x16 p0, p1; qkt(p0, p1, Kbase + slot, qr, negm, r32, hi);
        if (wq0 - (key0 + KVBLK - 1) < 128) {
            const int dbase = wq0 + r32 - key0 - 4 * hi;
#pragma unroll
            for (int r = 0; r < 16; ++r) { const int d0_ = dbase - ((r & 3) + 8 * (r >> 2)), d1_ = d0_ - 32;
                const int i0 = d0_ < 0 ? 0 : (d0_ > 128 ? 128 : d0_), i1 = d1_ < 0 ? 0 : (d1_ > 128 ? 128 : d1_);
                p0[r] = d0_ < 0 ? -1e30f : p0[r] + tab[i0]; p1[r] = d1_ < 0 ? -1e30f : p1[r] + tab[i1]; }
        }
        const float rm = rowmax(p0, p1);
        const bool live = rm > -1e29f; const bool need = live && (!set || rm > (float)THRL);
        if (__any(need)) {
            const float dl = live ? (set ? __builtin_fmaxf(rm, 0.f) : rm) : 0.f; const float f = set ? __builtin_amdgcn_exp2f(-dl) : 1.0f;
            mhat += dl; set = set || live; l_reg *= f;
#pragma unroll
            for (int r = 0; r < 16; ++r) { p0[r] -= dl; p1[r] -= dl; }
            if (hi == 0) wsf[r32] = f;
            asm volatile("s_waitcnt lgkmcnt(0)" ::: "memory");
#pragma unroll
            for (int d_ = 0; d_ < 2; ++d_)
#pragma unroll
                for (int r = 0; r < 16; ++r) o[d_][r] *= wsf[crow(r, hi)];
            asm volatile("s_waitcnt lgkmcnt(0)" ::: "memory");
        }
        float sacc = 0.f;
#pragma unroll
        for (int r = 0; r < 16; ++r) { p0[r] = __builtin_amdgcn_exp2f(p0[r]); p1[r] = __builtin_amdgcn_exp2f(p1[r]); sacc += p0[r] + p1[r]; }
        l_reg += sacc;
        u32x4 pw0 = (u32x4){PKW(p0, 0), PKW(p0, 2), PKW(p0, 4), PKW(p0, 6)}, pw1 = (u32x4){PKW(p0, 8), PKW(p0, 10), PKW(p0, 12), PKW(p0, 14)};
        u32x4 pw2 = (u32x4){PKW(p1, 0), PKW(p1, 2), PKW(p1, 4), PKW(p1, 6)}, pw3 = (u32x4){PKW(p1, 8), PKW(p1, 10), PKW(p1, 12), PKW(p1, 14)};
        pv(o, vb0 + slot, __builtin_bit_cast(bf16x8, pw0), __builtin_bit_cast(bf16x8, pw1), __builtin_bit_cast(bf16x8, pw2), __builtin_bit_cast(bf16x8, pw3));
    }
    { auto rr = __builtin_amdgcn_permlane32_swap(__float_as_uint(l_reg), __float_as_uint(l_reg), false, false); l_reg = __uint_as_float(rr[0]) + __uint_as_float(rr[1]); }
    if (hi == 0) wsf[32 + r32] = l_reg; asm volatile("s_waitcnt lgkmcnt(0)" ::: "memory");
    float rli[16];
#pragma unroll
    for (int r = 0; r < 16; ++r) rli[r] = __builtin_amdgcn_rcpf(wsf[32 + crow(r, hi)]);
    { u32x4 zr[4]; load_gate(zr, Z + (rowbase + wq0) * PITCH + h * HD, lane); store_gated(o, rli, lds + LDS_OST + wid * 4096, zr, O + (rowbase + wq0) * OPITCH + h * HD, lane, r32, hi); }
    asm volatile("s_waitcnt vmcnt(0) lgkmcnt(0)\n\ts_barrier" ::: "memory");
#undef DMA_K
#undef DMA_V
}

__device__ __forceinline__ void sb_unit(int b, int h, int qb, const bf16* Q, const bf16* __restrict__ K, const bf16* __restrict__ V, const bf16* Z, bf16* O, LAS char* lds) {
    int tid_ = threadIdx.x; asm volatile("" : "+v"(tid_));
    const int tid = tid_, lane = tid & 63, r32 = lane & 31, hi = lane >> 5; const int wid = __builtin_amdgcn_readfirstlane(tid >> 6);
    const long rowbase = (long)b * SEQ; const int q0 = qb * QB, wq0 = q0 + wid * QBLK;
    const bf16* Qw = Q + (rowbase + wq0) * PITCH + h * HD;
    const bf16* Kh = K + rowbase * PITCH + h * HD; const bf16* Vh = V + rowbase * PITCH + h * HD;
    const unsigned lds0 = (unsigned)(uintptr_t)lds;
    volatile LAS unsigned* flg = (volatile LAS unsigned*)(lds + LDS_FLAG);
    const bf16* ksrc = Kh + (long)lane * PITCH + wid * 8;
    const bf16* vsrc = Vh + (long)(16 * (wid & 3) + (lane >> 2)) * PITCH + (wid >> 2) * 32 + (lane & 3) * 8;
    const unsigned kdst = lds0 + LDS_K + wid * 1024, vdst = lds0 + LDS_V + wid * 1024;
#define DMA_K(t, slot) glds16(ksrc + (long)(t) * KVBLK * PITCH, (unsigned)__builtin_amdgcn_readfirstlane(kdst + (slot)))
#define DMA_V(t, slot) glds16(vsrc + (long)(t) * KVBLK * PITCH, (unsigned)__builtin_amdgcn_readfirstlane(vdst + (slot)))
    const int vb0 = (int)(lds0 + LDS_V) + ((lane >> 4) & 1) * 32 + (lane & 3) * 8 + (4 * hi + ((lane & 15) >> 2)) * 64;
    const lds_cptr Kbase = (lds_cptr)lds + LDS_K;
    const int NT = (q0 + QB) / KVBLK;
    if (tid < 16) flg[tid] = 0u;
    DMA_K(NT - 1, 0); DMA_V(NT - 1, 0);
    bf16x8 qr[4];
#pragma unroll
    for (int d0 = 0; d0 < 4; ++d0) qr[d0] = *reinterpret_cast<const bf16x8*>(&Qw[(long)r32 * PITCH + d0 * 16 + hi * 8]);
    f16x8 tA[2], ones;
#pragma unroll
    for (int s_ = 0; s_ < 2; ++s_)
#pragma unroll
        for (int jj = 0; jj < 8; ++jj) { const int key = 16 * s_ + 8 * (jj >> 2) + 4 * hi + (jj & 3); tA[s_][jj] = (key >= r32) ? (_Float16)1.0f : (_Float16)0.0f; }
#pragma unroll
    for (int jj = 0; jj < 8; ++jj) ones[jj] = (_Float16)1.0f;
    float carry = 0.f; bool done = false; f32x16 o[2]; o[0] = f32x16{}; o[1] = f32x16{};
    const f32x16 zero16 = f32x16{};
    for (int i = 0; i < NT; ++i) {
        const int t = NT - 1 - i, slot = (i & 1) * SLOTB;
        WAIT_BAR0();
        { volatile LAS unsigned* fr_ = flg + ((i & 1) ^ 1) * 8;
          const unsigned a = fr_[0] & fr_[1] & fr_[2] & fr_[3] & fr_[4] & fr_[5] & fr_[6] & fr_[7]; if (a != 0u) break; }
        if (t > 0) { DMA_K(t - 1, slot ^ SLOTB); DMA_V(t - 1, slot ^ SLOTB); }
        const int key0 = t * KVBLK;
        if (!(done || key0 > wq0 + QBLK - 1)) {
        f32x16 z0, z1; qkt(z0, z1, Kbase + slot, qr, zero16, r32, hi);
        const bool band = (key0 + KVBLK - 1 >= wq0);
        const int dbase = wq0 + r32 - key0 - 4 * hi;
        f32x16 l0, l1;
#pragma unroll
        for (int r = 0; r < 16; ++r) { const int d0_ = dbase - ((r & 3) + 8 * (r >> 2)), d1_ = d0_ - 32;
            float a = __builtin_fmaxf(z0[r], 0.f) + __builtin_amdgcn_logf(1.0f + __builtin_amdgcn_exp2f(-__builtin_fabsf(z0[r])));
            float c = __builtin_fmaxf(z1[r], 0.f) + __builtin_amdgcn_logf(1.0f + __builtin_amdgcn_exp2f(-__builtin_fabsf(z1[r])));
            if (band) { a = d0_ > 0 ? a : 0.f; c = d1_ > 0 ? c : 0.f; }
            l0[r] = a; l1[r] = c; }
        u32x4 lf0 = (u32x4){cvtpk_h(l0[0], l0[1]), cvtpk_h(l0[2], l0[3]), cvtpk_h(l0[4], l0[5]), cvtpk_h(l0[6], l0[7])}, lf1 = (u32x4){cvtpk_h(l0[8], l0[9]), cvtpk_h(l0[10], l0[11]), cvtpk_h(l0[12], l0[13]), cvtpk_h(l0[14], l0[15])};
        u32x4 lf2 = (u32x4){cvtpk_h(l1[0], l1[1]), cvtpk_h(l1[2], l1[3]), cvtpk_h(l1[4], l1[5]), cvtpk_h(l1[6], l1[7])}, lf3 = (u32x4){cvtpk_h(l1[8], l1[9]), cvtpk_h(l1[10], l1[11]), cvtpk_h(l1[12], l1[13]), cvtpk_h(l1[14], l1[15])};
        f32x16 ct;
#pragma unroll
        for (int r = 0; r < 16; ++r) ct[r] = carry;
        f32x16 i1 = __builtin_amdgcn_mfma_f32_32x32x16_f16(tA[0], __builtin_bit_cast(f16x8, lf2), ct, 0, 0, 0);
        i1 = __builtin_amdgcn_mfma_f32_32x32x16_f16(tA[1], __builtin_bit_cast(f16x8, lf3), i1, 0, 0, 0);
        f32x16 i0 = __builtin_amdgcn_mfma_f32_32x32x16_f16(ones, __builtin_bit_cast(f16x8, lf2), ct, 0, 0, 0);
        i0 = __builtin_amdgcn_mfma_f32_32x32x16_f16(ones, __builtin_bit_cast(f16x8, lf3), i0, 0, 0, 0);
        i0 = __builtin_amdgcn_mfma_f32_32x32x16_f16(tA[0], __builtin_bit_cast(f16x8, lf0), i0, 0, 0, 0);
        i0 = __builtin_amdgcn_mfma_f32_32x32x16_f16(tA[1], __builtin_bit_cast(f16x8, lf1), i0, 0, 0, 0);
#pragma unroll
        for (int r = 0; r < 16; ++r) { const int d0_ = dbase - ((r & 3) + 8 * (r >> 2)), d1_ = d0_ - 32;
            float a = __builtin_amdgcn_exp2f(z0[r] - i0[r]), c = __builtin_amdgcn_exp2f(z1[r] - i1[r]);
            if (band) { a = d0_ > 0 ? a : 0.f; c = d1_ > 0 ? c : 0.f; }
            z0[r] = a; z1[r] = c; }
        carry = lowhalf(i0[0]);
        u32x4 pw0 = (u32x4){PKW(z0, 0), PKW(z0, 2), PKW(z0, 4), PKW(z0, 6)}, pw1 = (u32x4){PKW(z0, 8), PKW(z0, 10), PKW(z0, 12), PKW(z0, 14)};
        u32x4 pw2 = (u32x4){PKW(z1, 0), PKW(z1, 2), PKW(z1, 4), PKW(z1, 6)}, pw3 = (u32x4){PKW(z1, 8), PKW(z1, 10), PKW(z1, 12), PKW(z1, 14)};
        pv(o, vb0 + slot, __builtin_bit_cast(bf16x8, pw0), __builtin_bit_cast(bf16x8, pw1), __builtin_bit_cast(bf16x8, pw2), __builtin_bit_cast(bf16x8, pw3));
        if (__all(carry >= SB_EXIT)) done = true;
        }
        if (lane == 0) flg[(i & 1) * 8 + wid] = done ? 1u : 0u;
    }
    { long ro_ = rowbase + wq0; asm volatile("" : "+s"(ro_)); u32x4 zr[4]; load_gate(zr, Z + ro_ * PITCH + h * HD, lane); store_gated(o, nullptr, lds + LDS_OST + wid * 4096, zr, O + ro_ * OPITCH + h * HD, lane, r32, hi); }
    asm volatile("s_waitcnt vmcnt(0) lgkmcnt(0)\n\ts_barrier" ::: "memory");
#undef DMA_K
#undef DMA_V
}

__device__ __forceinline__ void sb_unit_w(int b, int h, int qb, const bf16* Q, const bf16* __restrict__ K, const bf16* __restrict__ V, const bf16* Z, bf16* O, LAS char* lds) {
    int tid_ = threadIdx.x; asm volatile("" : "+v"(tid_));
    const int tid = tid_, lane = tid & 63, r32 = lane & 31, hi = lane >> 5; const int wid = __builtin_amdgcn_readfirstlane(tid >> 6);
    const long rowbase = (long)b * SEQ; const int wq0 = qb * QB + wid * QBLK;
    const bf16* Qw = Q + (rowbase + wq0) * PITCH + h * HD;
    const bf16* Kh = K + rowbase * PITCH + h * HD; const bf16* Vh = V + rowbase * PITCH + h * HD;
    LAS char* wl = lds + wid * 16384;
    const unsigned lds0 = (unsigned)(uintptr_t)wl;
    const bf16* ksrc = Kh + (long)(lane & 31) * PITCH + (lane >> 5) * 8;
    const bf16* vsrc = Vh + (long)(lane >> 2) * PITCH + (lane & 3) * 8;
#define DMA_T(key0, bf) do { const unsigned d_ = (unsigned)__builtin_amdgcn_readfirstlane(lds0 + (bf) * 8192); const bf16* k_ = ksrc + (long)(key0) * PITCH; const bf16* v_ = vsrc + (long)(key0) * PITCH; \
        _Pragma("unroll") for (int i_ = 0; i_ < 4; ++i_) glds16(k_ + i_ * 16, d_ + i_ * 1024); \
        _Pragma("unroll") for (int i_ = 0; i_ < 4; ++i_) glds16(v_ + (long)((i_ & 1) * 16) * PITCH + (i_ >> 1) * 32, d_ + 4096 + i_ * 1024); } while (0)
    const int kt0 = wq0 >> 5;
    DMA_T(kt0 * 32, 0);
    bf16x8 qr[4];
#pragma unroll
    for (int d0 = 0; d0 < 4; ++d0) qr[d0] = *reinterpret_cast<const bf16x8*>(&Qw[(long)r32 * PITCH + d0 * 16 + hi * 8]);
    u32x4 zr[4]; load_gate(zr, Z + (rowbase + wq0) * PITCH + h * HD, lane);
    f16x8 tA[2];
#pragma unroll
    for (int s_ = 0; s_ < 2; ++s_)
#pragma unroll
        for (int jj = 0; jj < 8; ++jj) { const int key = 16 * s_ + 8 * (jj >> 2) + 4 * hi + (jj & 3); tA[s_][jj] = (key >= r32) ? (_Float16)1.0f : (_Float16)0.0f; }
    float carry = 0.f; f32x16 o[2]; o[0] = f32x16{}; o[1] = f32x16{};
    const int vbl = (int)lds0 + 4096 + ((lane >> 4) & 1) * 32 + (lane & 3) * 8 + (4 * hi + ((lane & 15) >> 2)) * 64;
#pragma unroll 1
    for (int i = 0;; ++i) { const int kt = kt0 - i, bf = i & 1;
        if (kt > 0) { DMA_T((kt - 1) * 32, bf ^ 1); asm volatile("s_waitcnt vmcnt(8)" ::: "memory"); }
        else asm volatile("s_waitcnt vmcnt(0)" ::: "memory");
        const lds_cptr kb = (lds_cptr)wl + bf * 8192 + hi * 512 + r32 * 16;
        f32x16 z = f32x16{};
#pragma unroll
        for (int d0 = 0; d0 < 4; ++d0) { const bf16x8 a = *(const LAS bf16x8*)(kb + d0 * 1024); z = __builtin_amdgcn_mfma_f32_32x32x16_bf16(a, qr[d0], z, 0, 0, 0); }
        const bool band = (i == 0);
        f32x16 l;
#pragma unroll
        for (int r = 0; r < 16; ++r) { float a = __builtin_fmaxf(z[r], 0.f) + __builtin_amdgcn_logf(1.0f + __builtin_amdgcn_exp2f(-__builtin_fabsf(z[r])));
            if (band) a = (((r & 3) + 8 * (r >> 2) + 4 * hi) < r32) ? a : 0.f;
            l[r] = a; }
        const u32x4 lf0 = (u32x4){cvtpk_h(l[0], l[1]), cvtpk_h(l[2], l[3]), cvtpk_h(l[4], l[5]), cvtpk_h(l[6], l[7])}, lf1 = (u32x4){cvtpk_h(l[8], l[9]), cvtpk_h(l[10], l[11]), cvtpk_h(l[12], l[13]), cvtpk_h(l[14], l[15])};
        f32x16 ct;
#pragma unroll
        for (int r = 0; r < 16; ++r) ct[r] = carry;
        f32x16 ii = __builtin_amdgcn_mfma_f32_32x32x16_f16(tA[0], __builtin_bit_cast(f16x8, lf0), ct, 0, 0, 0);
        ii = __builtin_amdgcn_mfma_f32_32x32x16_f16(tA[1], __builtin_bit_cast(f16x8, lf1), ii, 0, 0, 0);
#pragma unroll
        for (int r = 0; r < 16; ++r) { float a = __builtin_amdgcn_exp2f(z[r] - ii[r]); if (band) a = (((r & 3) + 8 * (r >> 2) + 4 * hi) < r32) ? a : 0.f; z[r] = a; }
        carry = lowhalf(ii[0]);
        const u32x4 pw0 = (u32x4){cvtpk(z[0], z[1]), cvtpk(z[2], z[3]), cvtpk(z[4], z[5]), cvtpk(z[6], z[7])}, pw1 = (u32x4){cvtpk(z[8], z[9]), cvtpk(z[10], z[11]), cvtpk(z[12], z[13]), cvtpk(z[14], z[15])};
        { const int vb = vbl + bf * 8192;
#pragma unroll
          for (int d0 = 0; d0 < 2; ++d0) { s16x4 lo[2], hh[2];
#pragma unroll
            for (int ks = 0; ks < 2; ++ks) {
                asm volatile("ds_read_b64_tr_b16 %0,%1 offset:%c2" : "=&v"(lo[ks]) : "v"(vb), "i"(d0 * 2048 + ks * 1024) : "memory");
                asm volatile("ds_read_b64_tr_b16 %0,%1 offset:%c2" : "=&v"(hh[ks]) : "v"(vb), "i"(d0 * 2048 + ks * 1024 + 512) : "memory"); }
            asm volatile("s_waitcnt lgkmcnt(0)" ::: "memory"); __builtin_amdgcn_sched_barrier(0);
            o[d0] = __builtin_amdgcn_mfma_f32_32x32x16_bf16(__builtin_bit_cast(bf16x8, pw0), (bf16x8){lo[0][0], lo[0][1], lo[0][2], lo[0][3], hh[0][0], hh[0][1], hh[0][2], hh[0][3]}, o[d0], 0, 0, 0);
            o[d0] = __builtin_amdgcn_mfma_f32_32x32x16_bf16(__builtin_bit_cast(bf16x8, pw1), (bf16x8){lo[1][0], lo[1][1], lo[1][2], lo[1][3], hh[1][0], hh[1][1], hh[1][2], hh[1][3]}, o[d0], 0, 0, 0); } }
        if (kt == 0 || __all(carry >= SB_EXIT)) break;
    }
    asm volatile("s_waitcnt vmcnt(0) lgkmcnt(0)" ::: "memory");
    { long ro_ = rowbase + wq0; asm volatile("" : "+s"(ro_)); store_gated(o, nullptr, wl, zr, O + ro_ * OPITCH + h * HD, lane, r32, hi); }
    asm volatile("s_waitcnt lgkmcnt(0)\n\ts_barrier" ::: "memory");
#undef DMA_T
}
#undef PKW
#undef MX3
#define WAIT_BAR(N) asm volatile("s_waitcnt vmcnt(" #N ") lgkmcnt(0)\n\ts_barrier":::"memory")
template<int THRL> __device__ __forceinline__ void moba_unit_t(int b,int h,int qb,const bf16*Q,const bf16*__restrict__ K,const bf16*__restrict__ V,const bf16*Z,bf16*O,const float*ksum,const LAS float*tab,LAS char*shm){
  int tid_=threadIdx.x; asm volatile("":"+v"(tid_));
  const int tid=tid_,lane=tid&63,r32=lane&31,hi=lane>>5; const int wid=__builtin_amdgcn_readfirstlane(tid>>6);
  const long rowbase=(long)b*SEQ; const int q0=qb*QB, wq0=q0+wid*QBLK;
  const bf16*Qw=Q+(rowbase+q0+wid*QBLK)*PITCH+h*HD;
  const bf16*Kh=K+rowbase*PITCH+h*HD,*Vh=V+rowbase*PITCH+h*HD;
  const unsigned lds0=(unsigned)(uintptr_t)shm;
  LAS float*wsf=(LAS float*)(shm+LDS_WS)+wid*64;
  const bf16*ksrc=Kh+(long)lane*PITCH+wid*8;
  const bf16*vsrc=Vh+(long)(16*(wid&3)+(lane>>2))*PITCH+(wid>>2)*32+(lane&3)*8;
  const unsigned kdst=lds0+LDS_K+wid*1024, vdst=lds0+LDS_V+wid*1024;
  #define DMA_K(t,slot) glds16(ksrc+(long)(t)*KVBLK*PITCH,(unsigned)__builtin_amdgcn_readfirstlane(kdst+(slot)))
  #define DMA_V(t,slot) glds16(vsrc+(long)(t)*KVBLK*PITCH,(unsigned)__builtin_amdgcn_readfirstlane(vdst+(slot)))
  const int vb0=(int)(lds0+LDS_V)+((lane>>4)&1)*32+(lane&3)*8+(4*hi+((lane&15)>>2))*64;
  const lds_cptr Kbase=(lds_cptr)shm+LDS_K; bf16x8 kf[8];
  const lds_cptr shm3=(lds_cptr)shm; const lds_cptr kp0=shm3+LDS_K+hi*1024+r32*16; const lds_cptr vp0=shm3+LDS_V+((lane>>4)&1)*32+(lane&3)*8+(4*hi+((lane&15)>>2))*64;
  const int NT=(q0+QB)/KVBLK;
  UTS(0);
  { const bf16*zs_=Z+(rowbase+wq0+(lane>>3))*PITCH+h*HD+(lane&7)*8; const unsigned zd_=(unsigned)__builtin_amdgcn_readfirstlane(lds0+LDS_ZST+wid*4096);
    _Pragma("unroll") for(int i=0;i<4;++i)glds16(zs_+(long)(8*i)*PITCH,zd_+i*1024); }
  DMA_K(0,0);DMA_V(0,0);DMA_K(1,SLOTB);
  bf16x8 qr[4];
  #pragma unroll
  for(int d0=0;d0<4;++d0)qr[d0]=*reinterpret_cast<const bf16x8*>(&Qw[(long)r32*PITCH+d0*16+hi*8]);
  unsigned selmask=(qb<=TOPK)?((1u<<qb)-1u):0u;
  if(qb>TOPK)selmask=moba_select(ksum,qr,qb,r32,hi);
  bool on=(qb==0)||(selmask&1u);
  float mhat=0.f,l_reg=0.f;f32x16 o[2];o[0]=f32x16{};o[1]=f32x16{};f32x16 negm;
  { const float nm_=on?0.f:-1e30f; _Pragma("unroll") for(int r=0;r<16;++r)negm[r]=nm_; } asm volatile("":"+v"(negm));
  #define NEARMASK(P0,P1,tt) do{ const int key0_=(tt)*KVBLK; \
    if(key0_>wq0+QBLK-1){ _Pragma("unroll") for(int r=0;r<16;++r){P0[r]=-1e30f;P1[r]=-1e30f;} }     \
    else if(wq0-(key0_+KVBLK-1)<128){ const int dbase_=wq0+r32-key0_-4*hi+1; \
      _Pragma("unroll") for(int r=0;r<16;++r){ const int d0_=dbase_-((r&3)+8*(r>>2)),d1_=d0_-32; const int i0_=d0_<0?0:(d0_>129?129:d0_),i1_=d1_<0?0:(d1_>129?129:d1_); \
        P0[r]+=tab[i0_]; P1[r]+=tab[i1_]; if((r&3)==3){ asm volatile("":"+v"(P0),"+v"(P1)); SBAR(); } } } }while(0)
  #define CMASK(P0,P1,t) NEARMASK(P0,P1,t)
  #define BLKUPD(tile) do{ if((((tile))&3)==0){ const int blk_=(tile)>>2; on=(blk_==qb)||((selmask>>blk_)&1u); const float nm_=on?-mhat:-1e30f; \
      _Pragma("unroll") for(int r=0;r<16;++r)negm[r]=nm_; asm volatile("":"+v"(negm)); } }while(0)
  bool resc=false;
  #define START(P0,P1) do{ const float rm=rowmax(P0,P1); resc=false; \
    { const float dl=(rm>-1e29f)?rm:0.f; mhat=fadd_s(mhat,dl); \
      _Pragma("unroll") for(int r=0;r<16;++r){P0[r]=fsub_s(P0[r],dl);P1[r]=fsub_s(P1[r],dl);} \
      { const float nm_=on?-mhat:-1e30f; _Pragma("unroll") for(int r=0;r<16;++r)negm[r]=nm_; } asm volatile("":"+v"(negm)); } \
    _Pragma("unroll") for(int r=0;r<16;++r)P0[r]=__builtin_amdgcn_exp2f(P0[r]); }while(0)
  #define RESC() do{ if(resc){ asm volatile("s_waitcnt lgkmcnt(0)":::"memory"); \
      _Pragma("unroll") for(int d_=0;d_<2;++d_) _Pragma("unroll") for(int r=0;r<16;++r)o[d_][r]*=wsf[crow(r,hi)]; } }while(0)
  f32x16 pA0,pA1,pB0,pB1;
  int sl_prev=0,sl_cur=0,sl_next=SLOTB;
  #define ROT() do{sl_prev=sl_cur;sl_cur=sl_next;sl_next=(sl_next==(NSLOT-1)*SLOTB)?0:sl_next+SLOTB;}while(0)
  DMA_K(2,2*SLOTB);
  WAIT_BAR(3);
  UTS(1);
  qkt(pA0,pA1,Kbase,qr,negm,r32,hi);asm volatile("s_nop 15\n\ts_nop 7":"+v"(pA0),"+v"(pA1));CMASK(pA0,pA1,0);
  START(pA0,pA1);
  _Pragma("unroll") for(int r=0;r<16;++r)pA1[r]=__builtin_amdgcn_exp2f(pA1[r]);
  WAIT_BAR(0);
  DMA_K(3,0);DMA_V(1,SLOTB);
  ROT();
  kload8(kf,kp0+sl_cur);
  WAIT_BAR(2);
  s16x4 vlo[8],vhi[8]; u32x4 pw0,pw1,pw2,pw3;
  #define PKW(P,B) cvtpk_s(P[B],P[B+1])
  #define PAF(k) __builtin_bit_cast(bf16x8,pw##k)
  #define VFR(i) (bf16x8){vlo[i][0],vlo[i][1],vlo[i][2],vlo[i][3],vhi[i][0],vhi[i][1],vhi[i][2],vhi[i][3]}
  #define PIN(x) asm volatile("":"+v"(x))
  #define MX3(a,b,c) __builtin_fmaxf(__builtin_fmaxf((a),(b)),(c))
  #define GAPA(MF,A0,A1,A2,A3,W0,W1,PW) do{ MF; sacc+=A0; sacc+=A1; sacc+=A2; sacc+=A3; PIN(sacc); W0; W1; PIN(PW); SBAR(); }while(0)
  #define EX(v) __builtin_amdgcn_exp2f(v)
  #define GAPB(MF,X,B) do{ MF; X[B]=EX(X[B]); X[B+1]=EX(X[B+1]); X[B+2]=EX(X[B+2]); X[B+3]=EX(X[B+3]); PIN(X); SBAR(); }while(0)
  #define VRD(i) do{ vlo[i]=vtr(vp_+(((i)>>2)*4096+((i)&3)*1024)); vhi[i]=vtr(vp_+(((i)>>2)*4096+((i)&3)*1024+512)); }while(0)
  #define KRD(G,j) do{ if(G){ kload2(kf,kp0+sl_next,j); SBAR(); } }while(0)
  #define STEP(C0,C1,P0,P1,t,GK,GV,GL) do{ SBAR(); \
    const lds_cptr vp_=vp0+sl_prev; \
    VRD(0); SBAR(); float sacc=(P0[0]+P0[1]); \
    GAPA(C0=__builtin_amdgcn_mfma_f32_32x32x16_bf16(kf[0],qr[0],negm,0,0,0), P0[2],P0[3],P0[4],P0[5],     pw0[0]=PKW(P0,0), pw0[1]=PKW(P0,2), pw0); \
    VRD(4); SBAR(); GAPA(C1=__builtin_amdgcn_mfma_f32_32x32x16_bf16(kf[1],qr[0],negm,0,0,0), P0[6],P0[7],P0[8],P0[9],     pw0[2]=PKW(P0,4), pw0[3]=PKW(P0,6), pw0); \
    VRD(1); SBAR(); GAPA(C0=__builtin_amdgcn_mfma_f32_32x32x16_bf16(kf[2],qr[1],C0,0,0,0),   P0[10],P0[11],P0[12],P0[13], pw1[0]=PKW(P0,8), pw1[1]=PKW(P0,10), pw1); \
    VRD(5); SBAR(); GAPA(C1=__builtin_amdgcn_mfma_f32_32x32x16_bf16(kf[3],qr[1],C1,0,0,0),   P0[14],P0[15],P1[0],P1[1],   pw1[2]=PKW(P0,12),pw1[3]=PKW(P0,14), pw1); \
    VRD(2); SBAR(); GAPA(C0=__builtin_amdgcn_mfma_f32_32x32x16_bf16(kf[4],qr[2],C0,0,0,0),   P1[2],P1[3],P1[4],P1[5],     pw2[0]=PKW(P1,0), pw2[1]=PKW(P1,2), pw2); \
    VRD(6); SBAR(); GAPA(C1=__builtin_amdgcn_mfma_f32_32x32x16_bf16(kf[5],qr[2],C1,0,0,0),   P1[6],P1[7],P1[8],P1[9],     pw2[2]=PKW(P1,4), pw2[3]=PKW(P1,6), pw2); \
    VRD(3); SBAR(); GAPA(C0=__builtin_amdgcn_mfma_f32_32x32x16_bf16(kf[6],qr[3],C0,0,0,0),   P1[10],P1[11],P1[12],P1[13], pw3[0]=PKW(P1,8), pw3[1]=PKW(P1,10), pw3); \
    VRD(7); SBAR(); GAPA(C1=__builtin_amdgcn_mfma_f32_32x32x16_bf16(kf[7],qr[3],C1,0,0,0),   P1[14],P1[15],0.f,0.f,       pw3[2]=PKW(P1,12),pw3[3]=PKW(P1,14), pw3); \
    l_reg+=sacc; \
    if(GK){DMA_K((t)+3,sl_cur);} if(GV){DMA_V((t)+1,sl_next);} \
    CMASK(C0,C1,t); \
    { float a=MX3(C0[0],C0[1],C1[0]),b=MX3(C0[2],C0[3],C1[1]); a=MX3(a,C1[2],C1[3]); \
      _Pragma("unroll") for(int r=4;r<16;r+=4){a=MX3(a,C0[r],C0[r+1]);b=MX3(b,C0[r+2],C0[r+3]);a=MX3(a,C1[r],C1[r+1]);b=MX3(b,C1[r+2],C1[r+3]);} \
      float rm=__builtin_fmaxf(a,b); { auto rr=__builtin_amdgcn_permlane32_swap(__float_as_uint(rm),__float_as_uint(rm),false,false); rm=__builtin_fmaxf(__uint_as_float(rr[0]),__uint_as_float(rr[1])); } \
      resc=false; \
      if(__builtin_expect(__any(rm>(float)THRL),0)){ const float dl=__builtin_fmaxf(rm,0.f); mhat+=dl; \
        _Pragma("unroll") for(int r=0;r<16;++r){C0[r]-=dl;C1[r]-=dl;} \
        { const float nm_=on?-mhat:-1e30f; _Pragma("unroll") for(int r=0;r<16;++r)negm[r]=nm_; } asm volatile("":"+v"(negm)); \
        const float f=__builtin_amdgcn_exp2f(-dl); l_reg*=f; if(hi==0)wsf[r32]=f; resc=true; } } \
    SBAR(); \
    GAPB(o[0]=__builtin_amdgcn_mfma_f32_32x32x16_bf16(PAF(0),VFR(0),o[0],0,0,0), C0,0); \
    GAPB(o[1]=__builtin_amdgcn_mfma_f32_32x32x16_bf16(PAF(0),VFR(4),o[1],0,0,0), C0,4); \
    KRD(GL,0); GAPB(o[0]=__builtin_amdgcn_mfma_f32_32x32x16_bf16(PAF(1),VFR(1),o[0],0,0,0), C0,8); \
    KRD(GL,1); GAPB(o[1]=__builtin_amdgcn_mfma_f32_32x32x16_bf16(PAF(1),VFR(5),o[1],0,0,0), C0,12); \
    KRD(GL,2); GAPB(o[0]=__builtin_amdgcn_mfma_f32_32x32x16_bf16(PAF(2),VFR(2),o[0],0,0,0), C1,0); \
    KRD(GL,3); GAPB(o[1]=__builtin_amdgcn_mfma_f32_32x32x16_bf16(PAF(2),VFR(6),o[1],0,0,0), C1,4); \
    GAPB(o[0]=__builtin_amdgcn_mfma_f32_32x32x16_bf16(PAF(3),VFR(3),o[0],0,0,0), C1,8); \
    GAPB(o[1]=__builtin_amdgcn_mfma_f32_32x32x16_bf16(PAF(3),VFR(7),o[1],0,0,0), C1,12); \
    }while(0)
  int t=1;
  UTS(2);
  #undef CMASK
  #define CMASK(P0,P1,t) do{}while(0)
  for(;t+9<NT;t+=2){
    BLKUPD(t);   STEP(pB0,pB1,pA0,pA1,t,true,true,true);     WAIT_BAR(2); RESC(); ROT();
    BLKUPD(t+1); STEP(pA0,pA1,pB0,pB1,t+1,true,true,true);   WAIT_BAR(2); RESC(); ROT();
  }
  #undef CMASK
  #define CMASK(P0,P1,t) NEARMASK(P0,P1,t)
  #define ENDW(tt) do{ if((tt)+3<NT){WAIT_BAR(2);} else if((tt)+2<NT){WAIT_BAR(1);} else {WAIT_BAR(0);} }while(0)
  for(;t+1<NT;t+=2){
    BLKUPD(t);   STEP(pB0,pB1,pA0,pA1,t,(t+3<NT),(t+1<NT),(t+1<NT));       ENDW(t);   RESC(); ROT();
    BLKUPD(t+1); STEP(pA0,pA1,pB0,pB1,t+1,(t+4<NT),(t+2<NT),(t+2<NT));     ENDW(t+1); RESC(); ROT();
  }
  BLKUPD(NT-1); STEP(pB0,pB1,pA0,pA1,NT-1,false,false,false); RESC();
  { float sacc=pB0[0]+pB0[1]; _Pragma("unroll") for(int r=2;r<16;++r)sacc+=pB0[r]; _Pragma("unroll") for(int r=0;r<16;++r)sacc+=pB1[r]; l_reg+=sacc;
    pw0=(u32x4){PKW(pB0,0),PKW(pB0,2),PKW(pB0,4),PKW(pB0,6)};pw1=(u32x4){PKW(pB0,8),PKW(pB0,10),PKW(pB0,12),PKW(pB0,14)};pw2=(u32x4){PKW(pB1,0),PKW(pB1,2),PKW(pB1,4),PKW(pB1,6)};pw3=(u32x4){PKW(pB1,8),PKW(pB1,10),PKW(pB1,12),PKW(pB1,14)};
    SBAR(); pv(o,vb0+sl_cur,PAF(0),PAF(1),PAF(2),PAF(3)); }
  #undef PKW
  #undef PAF
  #undef VFR
  #undef PIN
  #undef MX3
  #undef GAPA
  #undef GAPB
  #undef EX
  #undef VRD
  #undef KRD
  #undef STEP
  #undef ENDW
  UTS(3);
  {auto rr=__builtin_amdgcn_permlane32_swap(__float_as_uint(l_reg),__float_as_uint(l_reg),false,false);l_reg=__uint_as_float(rr[0])+__uint_as_float(rr[1]);}
  if(hi==0)wsf[32+r32]=l_reg;asm volatile("s_waitcnt lgkmcnt(0)":::"memory");
  float rli[16];
  #pragma unroll
  for(int r=0;r<16;++r)rli[r]=__builtin_amdgcn_rcpf(wsf[32+crow(r,hi)]);
  { long ro_=rowbase+wq0; asm volatile("":"+s"(ro_)); u32x4 zr[4]; _Pragma("unroll") for(int i=0;i<4;++i)zr[i]=*(const LAS u32x4*)(shm+LDS_ZST+wid*4096+i*1024+lane*16); store_gated(o,rli,shm+LDS_OST+wid*4096,zr,O+ro_*OPITCH+h*HD,lane,r32,hi); }
  asm volatile("s_waitcnt lgkmcnt(0)\n\ts_barrier":::"memory");
  UTS(4);
  #undef DMA_K
  #undef DMA_V
  #undef CMASK
  #undef NEARMASK
  #undef BLKUPD
  #undef START
  #undef RESC
  #undef ROT
}
#undef WAIT_BAR
#undef SBAR
#undef WAIT_BAR0
}

typedef unsigned short bf16;
typedef unsigned v4u __attribute__((ext_vector_type(4)));
typedef float f32x4 __attribute__((ext_vector_type(4)));
typedef short bf16x8 __attribute__((ext_vector_type(8)));
typedef GAS unsigned gu32;
typedef GAS unsigned long long gu64;
#define RLX_AGENT __ATOMIC_RELAXED, __HIP_MEMORY_SCOPE_AGENT
#define LDS_WAIT() asm volatile("s_waitcnt lgkmcnt(0)" ::: "memory")
#define VM_WAIT() asm volatile("s_waitcnt vmcnt(0)" ::: "memory")
__device__ __forceinline__ unsigned long long rt() { return __builtin_amdgcn_s_memrealtime(); }
__device__ __forceinline__ unsigned f2bf(float f) { unsigned u = __builtin_bit_cast(unsigned, f); return (u + 0x7fffu + ((u >> 16) & 1u)) >> 16; }
__device__ __forceinline__ unsigned pk2(float lo, float hi) { return f2bf(lo) | (f2bf(hi) << 16); }

#define XB_TMO      128
#define XB_XCNT(j)  (256  + 64 * (j))
#define XB_XSUB(j)  (1280 + 64 * (j))
#define XB_XGEN(j)  (2304 + 64 * (j))
#define XB_TOP      3328
#define XB_TOPGEN   3392
#define XCD_BAR_WORDS 3456
#define XB_SPIN_CAP (1u << 18)

__device__ __forceinline__ unsigned xb_ld(unsigned* p)              { return __hip_atomic_load(p, __ATOMIC_RELAXED, __HIP_MEMORY_SCOPE_AGENT); }
__device__ __forceinline__ unsigned xb_add(unsigned* p, unsigned v) { return __hip_atomic_fetch_add(p, v, __ATOMIC_RELAXED, __HIP_MEMORY_SCOPE_AGENT); }
__device__ __forceinline__ unsigned xb_xcc_id() { return (unsigned)__builtin_amdgcn_s_getreg((3 << 11) | 20) & 0xFu; }
#define XB_SPIN(cond, bar) do { unsigned _sp = 0; while (cond) { __builtin_amdgcn_s_sleep(1); \
    if ((++_sp & 255u) == 0u) { if (xb_ld(&(bar)[XB_TMO])) break; if (_sp > XB_SPIN_CAP) { atomicAdd(&(bar)[XB_TMO], 1u); break; } } } } while (0)

struct XcdBarrier {
    unsigned* bar; unsigned x;
    volatile LAS unsigned* st;
};

__device__ __forceinline__ XcdBarrier xcd_barrier_post(unsigned* bar, volatile LAS unsigned* st) {
    XcdBarrier b; b.bar = bar; b.x = xb_xcc_id(); b.st = st;
    if (threadIdx.x == 0) (void)xb_add(&bar[XB_XCNT(b.x)], 1u);
    return b;
}
__device__ __forceinline__ void xcd_barrier_complete(unsigned* bar, unsigned x, unsigned& nloc, unsigned& nx) {
    const unsigned G = gridDim.x * gridDim.y * gridDim.z;
    unsigned sum, cnt, mine, sp = 0u;
    for (;;) {
        sum = 0u; cnt = 0u; mine = 0u;
#pragma unroll
        for (unsigned j = 0; j < 16; ++j) { const unsigned c = xb_ld(&bar[XB_XCNT(j)]); sum += c; cnt += (c > 0u) ? 1u : 0u; mine = (j == x) ? c : mine; }
        if (sum == G) break;
        __builtin_amdgcn_s_sleep(1);
        if ((++sp & 255u) == 0u) { if (xb_ld(&bar[XB_TMO])) break; if (sp > XB_SPIN_CAP) { atomicAdd(&bar[XB_TMO], 1u); break; } }
    }
    nloc = mine > 0u ? mine : 1u; nx = cnt > 0u ? cnt : 1u;
}

__device__ __forceinline__ void xcd_barrier(const XcdBarrier& b) {
    asm volatile("s_waitcnt vmcnt(0)" ::: "memory");
    __syncthreads();
    if (threadIdx.x == 0) {
        unsigned* bar = b.bar;
        __builtin_amdgcn_s_waitcnt(0);
        unsigned nloc = b.st[0], nx = b.st[1];
        if (nloc == 0u) { xcd_barrier_complete(bar, b.x, nloc, nx); b.st[0] = nloc; b.st[1] = nx; }
        const unsigned old = xb_add(&bar[XB_XSUB(b.x)], 1u);
        const unsigned gen = old / nloc;
        if (old + 1u == (gen + 1u) * nloc) {
            __builtin_amdgcn_fence(__ATOMIC_RELEASE, "agent");
            asm volatile("s_waitcnt vmcnt(0)" ::: "memory");
            const unsigned og = xb_add(&bar[XB_TOP], 1u);
            const unsigned tg = og / nx;
            if (og + 1u == (tg + 1u) * nx) xb_add(&bar[XB_TOPGEN], 1u);
            else XB_SPIN(xb_ld(&bar[XB_TOPGEN]) == tg, bar);
            __builtin_amdgcn_fence(__ATOMIC_ACQUIRE, "agent");
            xb_add(&bar[XB_XGEN(b.x)], 1u);
            asm volatile("s_waitcnt vmcnt(0)" ::: "memory");
        } else {
            XB_SPIN(xb_ld(&bar[XB_XGEN(b.x)]) == gen, bar);
            __builtin_amdgcn_fence(__ATOMIC_ACQUIRE, "agent");
            asm volatile("s_waitcnt vmcnt(0)" ::: "memory");
        }
    }
    __syncthreads();
}


constexpr int NWAVES = 8;
constexpr int RING_OFF = 0, RING_BYTES = 131072;
constexpr int LDSCTL_OFF = RING_BYTES, MISC_OFF = LDSCTL_OFF + 320;
constexpr int LDS_BYTES = 147456;
static_assert(attn::LDS_BYTES <= RING_BYTES && MISC_OFF + 128 <= LDS_BYTES, "LDS map");

struct Frame {
    LAS unsigned char* lds; volatile LAS unsigned* MISC; gu32* ctl;
    int tid, lane, wave, vcu, G;
};
__device__ __forceinline__ float wave_sum(float v) {
#pragma unroll
    for (int o = 1; o < 64; o <<= 1) v += __shfl_xor(v, o);
    return v;
}
template <int ROWMAP>
__device__ __forceinline__ void p0_transpose_item(const float* Wsrc, int K, int N, bf16* WT, int ldt, int koff, LAS float* scr, int item, int lane) {
    const int nblk = N / 32, kb = item / nblk, nb = item % nblk, k0 = 64 * kb, n0 = 32 * nb;
    float t[32];
#pragma unroll
    for (int i = 0; i < 32; ++i) t[i] = Wsrc[(size_t)(k0 + 2 * i + (lane >> 5)) * N + n0 + (lane & 31)];
#pragma unroll
    for (int i = 0; i < 32; ++i) scr[(2 * i + (lane >> 5)) * 33 + (lane & 31)] = t[i];
    LDS_WAIT(); asm volatile("" ::: "memory");
    const int c = lane & 7; const int drow0 = (ROWMAP == 1) ? win_row_of_col(n0) : phys_of_actual(n0);
#pragma unroll
    for (int j = 0; j < 4; ++j) { const int n = (lane >> 3) + 8 * j; const LAS float* s = scr + (8 * c) * 33 + n;
        v4u o; o.x = pk2(s[0 * 33], s[1 * 33]); o.y = pk2(s[2 * 33], s[3 * 33]); o.z = pk2(s[4 * 33], s[5 * 33]); o.w = pk2(s[6 * 33], s[7 * 33]);
        *(GAS v4u*)(WT + (size_t)(drow0 + n) * ldt + koff + k0 + 8 * c) = o; }
    LDS_WAIT(); asm volatile("" ::: "memory");
}
template <int NR>
__device__ __forceinline__ void rms_rows_to_bf16(const float* xrow, const float* nw, bf16* orow, int lane) {
    f32x4 v[NR][4];
#pragma unroll
    for (int r = 0; r < NR; ++r) { const GAS f32x4* xr = (const GAS f32x4*)(xrow + (size_t)r * DM) + lane;
#pragma unroll
        for (int j = 0; j < 4; ++j) v[r][j] = xr[64 * j]; }
    const GAS f32x4* wr_ = (const GAS f32x4*)nw + lane; f32x4 w[4];
#pragma unroll
    for (int j = 0; j < 4; ++j) w[j] = wr_[64 * j];
#pragma unroll
    for (int r = 0; r < NR; ++r) { float s = 0.f;
#pragma unroll
        for (int j = 0; j < 4; ++j) s += (v[r][j].x * v[r][j].x + v[r][j].y * v[r][j].y) + (v[r][j].z * v[r][j].z + v[r][j].w * v[r][j].w);
        const float rstd = 1.f / sqrtf(wave_sum(s) * (1.f / DM) + EPS);
        GAS unsigned long long* o8 = (GAS unsigned long long*)(orow + (size_t)r * DM) + lane;
#pragma unroll
        for (int j = 0; j < 4; ++j) o8[64 * j] = (unsigned long long)pk2(v[r][j].x * rstd * w[j].x, v[r][j].y * rstd * w[j].y) | ((unsigned long long)pk2(v[r][j].z * rstd * w[j].z, v[r][j].w * rstd * w[j].w) << 32); }
}

struct Args { const float* in[10]; float* out; unsigned char* ws; int ph_lo, ph_hi; };

__global__ void __launch_bounds__(NWAVES * 64, 2) hybrid_fwd(Args args) {
    extern __shared__ __attribute__((aligned(16))) unsigned char lds[];
    Frame F;
    F.lds = (LAS unsigned char*)lds; F.MISC = (volatile LAS unsigned*)(F.lds + MISC_OFF);
    F.tid = threadIdx.x; F.lane = F.tid & 63; F.wave = __builtin_amdgcn_readfirstlane(F.tid >> 6);
    F.G = gridDim.x; { const int bx = blockIdx.x; F.vcu = (F.G % 8 == 0) ? (bx % 8) * (F.G / 8) + bx / 8 : bx; }
    unsigned char* ws = args.ws; F.ctl = (gu32*)(ws + WS_CTL);
    for (int u = F.tid; u < (LDS_BYTES - LDSCTL_OFF) / 4; u += NWAVES * 64) ((LAS unsigned*)(F.lds + LDSCTL_OFF))[u] = 0u;
    __syncthreads();
    const int lo = args.ph_lo, hi = args.ph_hi;
    const bool multi = (hi - lo) > 1;
    XcdBarrier bar; bar.bar = (unsigned*)(F.ctl + CW_BAR); bar.x = 0; bar.st = nullptr;
    if (multi) bar = xcd_barrier_post((unsigned*)(F.ctl + CW_BAR), F.MISC + 8);
#define IN(k) (lo <= (k) && (k) < hi)
    unsigned long long* stamps = (unsigned long long*)(ws + 128 * 1024);
#ifndef PT_K
#define PT_K (-1)
#endif
#ifndef PT_KIND
#define PT_KIND 0
#endif
#ifndef PT_AMP
#define PT_AMP 16
#endif
#define STAMP(k) do { if (PT_K >= 0) { if (F.tid == 0) __hip_atomic_store(stamps + (k) * 256 + blockIdx.x, rt(), __ATOMIC_RELAXED, __HIP_MEMORY_SCOPE_AGENT); } } while (0)
#define PTDELAY(kb) do { if (PT_K == (kb) && blockIdx.x == 0 && F.wave == 0) { \
        unsigned long long mn_ = ~0ull, mx_ = 0ull; \
        for (int j_ = F.lane; j_ < F.G; j_ += 64) { const unsigned long long v_ = __hip_atomic_load(stamps + ((PT_KIND == 3) ? 0 : (2 * (kb) + 1)) * 256 + j_, __ATOMIC_RELAXED, __HIP_MEMORY_SCOPE_AGENT); mn_ = v_ < mn_ ? v_ : mn_; mx_ = v_ > mx_ ? v_ : mx_; } \
        for (int o_ = 1; o_ < 64; o_ <<= 1) { const unsigned long long a_ = __shfl_xor(mn_, o_), b_ = __shfl_xor(mx_, o_); mn_ = a_ < mn_ ? a_ : mn_; mx_ = b_ > mx_ ? b_ : mx_; } \
        const unsigned long long ex_ = __hip_atomic_load(stamps + (2 * (kb) + 2) * 256, __ATOMIC_RELAXED, __HIP_MEMORY_SCOPE_AGENT), pv_ = __hip_atomic_load(stamps + (2 * (kb)) * 256, __ATOMIC_RELAXED, __HIP_MEMORY_SCOPE_AGENT); \
        const unsigned long long X_ = (PT_KIND == 0 || PT_KIND == 3) ? (mx_ - mn_) : (PT_KIND == 1) ? (ex_ - mx_) : (PT_KIND == 4) ? (mx_ - __hip_atomic_load(stamps, __ATOMIC_RELAXED, __HIP_MEMORY_SCOPE_AGENT)) : (mx_ - pv_);         \
        const unsigned long long t0_ = rt(); while (rt() - t0_ < (unsigned long long)PT_AMP * X_) __builtin_amdgcn_s_sleep(8); } \
      if (PT_K == (kb)) __syncthreads(); } while (0)
    STAMP(0);
#ifndef DUP_MASK
#define DUP_MASK 0
#endif
#define NREP(k) (((DUP_MASK >> (k)) & 1) ? 2 : 1)
#define BOTH(k) (IN(k) && IN((k) + 1))
    const float* x = args.in[0];
    bf16* Wt_in = (bf16*)(ws + WS_WIN); bf16* Wt_up = (bf16*)(ws + WS_WUP); bf16* Wt_out = (bf16*)(ws + WS_WOUT);
    bf16* Hb = (bf16*)(ws + WS_H);

#ifndef NPASS
#define NPASS 1
#endif
#ifndef WARM_NEXT
#define WARM_NEXT 0
#endif
#ifndef BARX
#define BARX 1
#endif
#if BARX == 1
#define GBAR() xcd_barrier(bar)
#else
#define GBAR() do { for (int bx_ = 0; bx_ < BARX; ++bx_) xcd_barrier(bar); } while (0)
#endif
#ifndef NO_P0
    if (IN(0)) {
        LAS float* scr = (LAS float*)(F.lds + RING_OFF + F.wave * 16384);
        const int gw = F.vcu * NWAVES + F.wave, NGW = F.G * NWAVES;
        constexpr int I_IN = (DM / 64) * (INW / 32), I_UP = (W / 64) * (DM / 32), I_OUT = (DM / 64) * (DM / 32);
        constexpr int NITEMS = I_IN + 2 * I_UP + I_OUT;
        for (int rep = 0; rep < NREP(0); ++rep) {
        for (int it = gw; it < NITEMS; it += NGW) { int r = it;
            if (r < I_IN) { p0_transpose_item<1>(args.in[2], DM, INW, Wt_in, DM, 0, scr, r, F.lane); continue; } r -= I_IN;
            if (r < I_UP) { p0_transpose_item<0>(args.in[7], W, DM, Wt_up, DM, 0, scr, r, F.lane); continue; } r -= I_UP;
            if (r < I_UP) { p0_transpose_item<0>(args.in[8], W, DM, Wt_up, DM, W, scr, r, F.lane); continue; } r -= I_UP;
            p0_transpose_item<0>(args.in[9], DM, DM, Wt_out, DM, 0, scr, r, F.lane); }
        for (int m = 4 * gw; m < M; m += 4 * NGW) rms_rows_to_bf16<4>(x + (size_t)m * DM, args.in[1], Hb + (size_t)m * DM, F.lane);
        }
        STAMP(1); if (BOTH(0)) GBAR(); STAMP(2); PTDELAY(0);
    }
#endif
#ifndef NO_P1
    if (IN(1)) {
        pg8::Gemm g{Hb, Wt_in, M, INW, DM, DM, DM}; pg8::StaticOrder S; S.init(M, INW, F.G, (int)blockIdx.x);
        pg8::EpiProj E{ws, args.in[3], args.in[4], args.in[5], 0};
#ifdef STAGGER_TICKS
        { const unsigned long long t0_ = rt(); const unsigned long long dly_ = (unsigned long long)((blockIdx.x >> 3) & 3) * STAGGER_TICKS; while (rt() - t0_ < dly_) __builtin_amdgcn_s_sleep(4); }
#endif
        for (int rep = 0; rep < NREP(1); ++rep) {
#ifdef DUP_NOSTORE
        if (rep == 1) E.nostore = 1;
#endif
        pg8::gemm_phase<pg8::EpiProj, pg8::StaticOrder, true, true>(F.lds + RING_OFF, g, S, E); }
        STAMP(3); if (BOTH(1)) GBAR(); STAMP(4); PTDELAY(1);
    }
#endif
#ifndef NO_P2
    if (IN(2)) {
        const bf16* QA = (const bf16*)(ws + WS_P); const bf16* KA = QA + (size_t)M * W; const bf16* VA = KA + (size_t)M * W; const bf16* ZA = VA + (size_t)M * W;
        const bf16* QB_ = ZA + (size_t)M * W; const bf16* KB_ = QB_ + (size_t)M * W; const bf16* VB_ = KB_ + (size_t)M * W; const bf16* ZB_ = VB_ + (size_t)M * W;
        LAS float* tabs = (LAS float*)(F.lds + LDSCTL_OFF + 10240);
        attn::moba_tables(tabs, args.in[6], F.tid); __syncthreads();
        const unsigned myx = xb_xcc_id() & 7u;
        const unsigned dummy = (unsigned)__builtin_amdgcn_readfirstlane((unsigned)(uintptr_t)(F.lds + LDSCTL_OFF + 2048) + (unsigned)F.wave * 1024u);
#pragma unroll 1
        for (int pass = 0; pass < NREP(2); ++pass) {
#define POP_DESC(dst) do { dst = 0xffffffffu; while (qi < 8) { const unsigned q_ = (myx + (unsigned)qi) & 7u; \
            const unsigned u_ = __hip_atomic_fetch_add((unsigned*)(F.ctl + CW_QUEUE + 64 * q_ + 1024 * pass), 1u, __ATOMIC_RELAXED, __HIP_MEMORY_SCOPE_AGENT); if (u_ < 256u) { dst = (q_ << 8) | u_; break; } ++qi; } } while (0)
        if (F.tid == 0) { int qi = 0; unsigned d0_, d1_; POP_DESC(d0_); POP_DESC(d1_); F.MISC[20] = d0_; F.MISC[21] = d1_; F.MISC[22] = (unsigned)qi; }
        __syncthreads(); unsigned cur = F.MISC[20], nxt = F.MISC[21]; __syncthreads();
#pragma unroll 1
        while (cur != 0xffffffffu) {
#define DECODE(d, is_sb, b, h, qb) const int cls_##b = (int)(((d) & 255u) >> 4), bh_##b = 16 * (int)((d) >> 8) + (int)((d) & 15u); const int b = bh_##b >> 3, h = bh_##b & 7; \
            const bool is_sb = (cls_##b >= 6 && cls_##b <= 12) || cls_##b == 14; const int qb = (cls_##b < 6) ? 7 - cls_##b : (cls_##b <= 12) ? 13 - cls_##b : (cls_##b == 13) ? 1 : 0
            if (WARM_NEXT && nxt != 0xffffffffu) { DECODE(nxt, nsb, nb, nh, nqb); const long r0 = (long)nb * SEQ, rq = r0 + nqb * 256;
                if (!nsb) { attn::warm_rows(KA + nh * 64, r0, 3, dummy, F.wave, F.lane); attn::warm_rows(VA + nh * 64, r0, 1, dummy, F.wave, F.lane); attn::warm_rows(QA + nh * 64, rq, 4, dummy, F.wave, F.lane); attn::warm_rows(ZA + nh * 64, rq, 4, dummy, F.wave, F.lane); }
                else { attn::warm_rows(KB_ + nh * 64, rq, 4, dummy, F.wave, F.lane); attn::warm_rows(VB_ + nh * 64, rq, 4, dummy, F.wave, F.lane); attn::warm_rows(QB_ + nh * 64, rq, 4, dummy, F.wave, F.lane); attn::warm_rows(ZB_ + nh * 64, rq, 4, dummy, F.wave, F.lane); } }
            { DECODE(cur, csb, cb, ch, cqb);
                if (!csb) attn::moba_unit_t<8>(cb, ch, cqb, QA, KA, VA, ZA, Hb, (const float*)(ws + WS_KSUM) + (size_t)(cb * 8 + ch) * NBLK * 64, tabs + ch * 132, (LAS char*)(F.lds + RING_OFF));
                else attn::sb_unit_w(cb, ch, cqb, QB_, KB_, VB_, ZB_, Hb + W, (LAS char*)(F.lds + RING_OFF)); }
            if (F.tid == 0) { unsigned nn = 0xffffffffu; if (nxt != 0xffffffffu) { int qi = (int)F.MISC[22]; POP_DESC(nn); F.MISC[22] = (unsigned)qi; } F.MISC[20] = nn; }
            __syncthreads();
            cur = nxt; nxt = F.MISC[20];
        }
#undef POP_DESC
#undef DECODE
        }
#ifdef UT_PROBE
        if (blockIdx.x == 0 && F.tid == 0) { volatile LAS unsigned long long* u_ = (volatile LAS unsigned long long*)(F.lds + 132096); const unsigned long long X_ = u_[UT_B] - u_[UT_A];
            const unsigned long long t0_ = rt(); while (rt() - t0_ < (unsigned long long)UT_AMP * X_) __builtin_amdgcn_s_sleep(8); }
        __syncthreads();
#endif
        STAMP(5); if (BOTH(2)) GBAR(); STAMP(6); PTDELAY(2);
    }
#endif
#ifndef NO_P3
    if (IN(3)) {
        pg8::Gemm g{Hb, Wt_up, M, DM, DM, DM, DM}; pg8::StaticOrder S; S.init(M, DM, F.G, (int)blockIdx.x, NREP(3));
        pg8::EpiY E{(const bf16*)(ws + WS_GR), (const bf16*)(ws + WS_GB), (bf16*)(ws + WS_Y)};
        pg8::gemm_phase<pg8::EpiY, pg8::StaticOrder, true, true>(F.lds + RING_OFF, g, S, E);
        STAMP(7); if (BOTH(3)) GBAR(); STAMP(8); PTDELAY(3);
    }
#endif
#ifndef NO_P4
    if (IN(4)) {
        pg8::Gemm g{(const bf16*)(ws + WS_Y), Wt_out, M, DM, DM, DM, DM}; pg8::StaticOrder S; S.init(M, DM, F.G, (int)blockIdx.x);
        pg8::EpiOut E{x, args.out};
        for (int rep = 0; rep < NREP(4); ++rep)
        pg8::gemm_phase<pg8::EpiOut, pg8::StaticOrder, true, true>(F.lds + RING_OFF, g, S, E);
    }
#endif
    if (PT_K == 4) { STAMP(9); xcd_barrier(bar); STAMP(10); PTDELAY(4); }
#undef IN
#undef BOTH
}

__global__ void noop_kernel(int* p) { if (threadIdx.x == 1000) p[0] = 1; }
#ifndef MK_CUTS
#define MK_CUTS 1
#endif
extern "C" void kernel_launch(void* const* d_in, const int* in_sizes, int n_in, void* d_out, int out_size, void* d_ws, size_t ws_size, hipStream_t stream) {
    static int grid = 0;
    if (grid == 0) {
        if (n_in != 10 || in_sizes[0] != M * DM || out_size != M * DM || ws_size < WS_END) { fprintf(stderr, "kernel_launch: unexpected shapes / workspace (%d inputs, x %d, out %d, ws %zu)\n", n_in, n_in > 0 ? in_sizes[0] : -1, out_size, ws_size); grid = -1; return; }
        int dev = 0, cus = 0, per_cu = 0;
        if (hipGetDevice(&dev) != hipSuccess || hipDeviceGetAttribute(&cus, hipDeviceAttributeMultiprocessorCount, dev) != hipSuccess) { grid = -1; return; }
        if (hipFuncSetAttribute((const void*)hybrid_fwd, hipFuncAttributeMaxDynamicSharedMemorySize, LDS_BYTES) != hipSuccess) { fprintf(stderr, "kernel_launch: hipFuncSetAttribute failed\n"); grid = -1; return; }
        if (hipOccupancyMaxActiveBlocksPerMultiprocessor(&per_cu, (const void*)hybrid_fwd, NWAVES * 64, LDS_BYTES) != hipSuccess || per_cu < 1) fprintf(stderr, "kernel_launch: note: occupancy query reports %d\n", per_cu);
        (void)hipGetLastError();
        grid = cus;
    }
    if (grid < 0) return;
#ifdef XMEMSET
    for (int i = 0; i < XMEMSET; ++i) (void)hipMemsetAsync((char*)d_ws + WS_CTL, 0, CTL_ZERO_BYTES, stream);
#endif
#ifdef XKERNEL
    for (int i = 0; i < XKERNEL; ++i) hipLaunchKernelGGL(noop_kernel, dim3(1), dim3(64), 0, stream, (int*)d_ws + 300000);
#endif
    if (hipMemsetAsync((char*)d_ws + WS_CTL, 0, CTL_ZERO_BYTES, stream) != hipSuccess) return;
    Args a{};
    for (int i = 0; i < 10; ++i) a.in[i] = (const float*)d_in[i];
    a.out = (float*)d_out; a.ws = (unsigned char*)d_ws;
    if (MK_CUTS == 1) { a.ph_lo = 0; a.ph_hi = 5; for (int pass = 0; pass < NPASS; ++pass) { if (pass) hipMemsetAsync((char*)d_ws + WS_CTL, 0, CTL_ZERO_BYTES, stream); hipLaunchKernelGGL(hybrid_fwd, dim3(grid), dim3(NWAVES * 64), LDS_BYTES, stream, a); } }
    else for (int p = 0; p < 5; ++p) { a.ph_lo = p; a.ph_hi = p + 1; hipLaunchKernelGGL(hybrid_fwd, dim3(grid), dim3(NWAVES * 64), LDS_BYTES, stream, a); }
}
```

```cpp
#include <hip/hip_runtime.h>
#include <hip/hip_bf16.h>
#include <cstdio>
#include <cstdint>

namespace cfg {
constexpr int BATCH = 16, SEQ = 2048, DM = 1024, M = BATCH * SEQ;
constexpr int NH = 8, HD = 64, W = 512, INW = 6144;
constexpr int MBLK = 256, NBLK = SEQ / MBLK, TOPK = 3;
constexpr float EPS = 1e-6f;
constexpr float LOG2E = 1.4426950408889634f;
constexpr float C2 = 0.125f * LOG2E;
#ifndef SB_EXIT_BITS
#define SB_EXIT_BITS 150
#endif
constexpr float SB_EXIT = (float)SB_EXIT_BITS;
constexpr size_t MiB = 1u << 20;
constexpr size_t WS_CTL = 0, CTL_ZERO_BYTES = 1 * MiB, WS_KSUM = 512 * 1024;
constexpr size_t WS_WIN = 2 * MiB, WS_WUP = 14 * MiB, WS_WOUT = 16 * MiB;
constexpr size_t WS_H = 20 * MiB;
constexpr size_t WS_P = 84 * MiB;
constexpr size_t WS_GR = 340 * MiB, WS_GB = 404 * MiB;
constexpr size_t WS_Y = 84 * MiB;
constexpr size_t WS_END = 468 * MiB;
constexpr int CW_TMO = 0, CW_BAR = 4096, CW_QUEUE = 8192;
}
using namespace cfg;
#define GAS __attribute__((address_space(1)))
#define LAS __attribute__((address_space(3)))

__host__ __device__ __forceinline__ int phys_of_actual(int col) { const int a = col & 255; return (col & ~255) + 128 * ((a >> 5) & 1) + 32 * (a >> 6) + (a & 31); }
__host__ __device__ __forceinline__ int win_row_of_col(int n) { if (n < 4096) return phys_of_actual(n); const int g = n - 4096, which = g >> 10, c = g & 1023; return (16 + (c >> 7)) * 256 + 128 * which + (c & 127); }

__constant__ unsigned char T5B[128] = {0, 1, 2, 3, 4, 5, 6, 7, 8, 9, 10, 11, 12, 13, 14, 15, 16, 16, 16, 17, 17, 18, 18, 18, 19, 19, 19, 20, 20, 20, 20, 21, 21, 21, 21, 22, 22, 22, 22, 22, 23, 23, 23, 23, 23, 23, 24, 24, 24, 24, 24, 24, 25, 25, 25, 25, 25, 25, 25, 26, 26, 26, 26, 26, 26, 26, 26, 27, 27, 27, 27, 27, 27, 27, 27, 27, 27, 28, 28, 28, 28, 28, 28, 28, 28, 28, 28, 29, 29, 29, 29, 29, 29, 29, 29, 29, 29, 29, 29, 30, 30, 30, 30, 30, 30, 30, 30, 30, 30, 30, 30, 30, 30, 31, 31, 31, 31, 31, 31, 31, 31, 31, 31, 31, 31, 31, 31, 31};

namespace pg8 {
#define PG8_LAS __attribute__((address_space(3)))
typedef unsigned short bf16_t;
typedef short bf16x8 __attribute__((ext_vector_type(8)));
typedef float f32x4 __attribute__((ext_vector_type(4)));
typedef unsigned u32x4 __attribute__((ext_vector_type(4)));
constexpr int BM = 256, BK = 64, HALF = 128, HTB = HALF * BK * 2  , STAGE_BYTES = 8 * HTB, NXCD = 8, WGM = 8;

__host__ __device__ __forceinline__ int lds_byte(int r, int c) { const int st = (r >> 4) * 2 + (c >> 5), rr = r & 15, cc = c & 31, ob = rr * 64 + cc * 2; return st * 1024 + (ob ^ (((ob >> 9) & 1) << 5)); }
__host__ __device__ __forceinline__ void stage_rc(int b, int& R, int& C) { const int st = b / 1024, sb = b % 1024, swz = sb ^ (((sb >> 9) & 1) << 5); R = (st >> 1) * 16 + swz / 64; C = (st & 1) * 32 + (swz % 64) / 2; }
__host__ __device__ __forceinline__ int perm32(int rho) { const int n = rho >> 4, i = rho & 15; return 8 * (i >> 2) + 4 * n + (i & 3); }

struct Unit { int pm, pn; };
struct Gemm { const bf16_t* A; const bf16_t* Bt; int M, N, K, lda, ldb; };

struct StaticOrder {
    int nM, nN, nwg, G, c, dup;
    __host__ __device__ void init(int M, int N, int G_, int c_, int dup_ = 1) { nM = M / BM; nN = N / BM; nwg = nM * nN; G = G_; c = c_; dup = dup_; }
    __host__ __device__ bool next(int i, Unit& u) const {
        const long L = (long)(i / dup) * G + c; if (L >= nwg) return false;
        int wgid = (int)L; { const int q = nwg / NXCD, r = nwg % NXCD, xcd = wgid % NXCD, off = wgid / NXCD; wgid = (xcd < r ? xcd * (q + 1) : r * (q + 1) + (xcd - r) * q) + off; }
        const int nig = WGM * nN, gid = wgid / nig, fm = gid * WGM, gsz = (nM - fm) < WGM ? (nM - fm) : WGM;
        u.pm = fm + ((wgid % nig) % gsz); u.pn = (wgid % nig) / gsz; return true;
    }
    __device__ __forceinline__ void a_ready(const Unit&) const {}
    __device__ __forceinline__ void done(const Unit&) const {}
};


__device__ __forceinline__ unsigned cvt_pk_bf16(float lo, float hi) { unsigned r; asm volatile("v_cvt_pk_bf16_f32 %0, %1, %2" : "=v"(r) : "v"(lo), "v"(hi)); return r; }
__device__ __forceinline__ float sigm(float x) { return __builtin_amdgcn_rcpf(1.0f + __builtin_amdgcn_exp2f(-LOG2E * x)); }
__device__ __forceinline__ u32x4 pack8(const f32x4& a, const f32x4& b) { u32x4 w; w.x = cvt_pk_bf16(a[0], a[1]); w.y = cvt_pk_bf16(a[2], a[3]); w.z = cvt_pk_bf16(b[0], b[1]); w.w = cvt_pk_bf16(b[2], b[3]); return w; }
#ifndef WT_STORES
#define WT_STORES 0
#endif
#ifndef NT_STORES
#define NT_STORES 1
#endif
#ifndef NT_LOADS
#define NT_LOADS 0
#endif
#ifndef WARM_GB
#define WARM_GB 0
#endif
#ifndef EPIY_FENCE
#define EPIY_FENCE 0
#endif
__device__ __forceinline__ void st16(void* p, const u32x4& v) {
#if WT_STORES
    asm volatile("global_store_dwordx4 %0, %1, off sc1\n\ts_nop 1" :: "v"(p), "v"(v) : "memory");
#elif NT_STORES
    __builtin_nontemporal_store(v, (u32x4*)p);
#else
    *(u32x4*)p = v;
#endif
}
__device__ __forceinline__ void unpack8(const u32x4& w, f32x4& a, f32x4& b) {
    a[0] = __uint_as_float(w.x << 16); a[1] = __uint_as_float(w.x & 0xffff0000u); a[2] = __uint_as_float(w.y << 16); a[3] = __uint_as_float(w.y & 0xffff0000u);
    b[0] = __uint_as_float(w.z << 16); b[1] = __uint_as_float(w.z & 0xffff0000u); b[2] = __uint_as_float(w.w << 16); b[3] = __uint_as_float(w.w & 0xffff0000u); }

__device__ __forceinline__ void st16p(void* p, const u32x4& v) { *(u32x4*)p = v; }
#ifndef NT_QKVZ
#define NT_QKVZ 1
#endif
struct EpiProj {
    static constexpr bool PERM = true, AFTER_DRAIN = false, MIDK = false;
    unsigned char* ws; const float* gbias; const float* qnw; const float* knw; int nostore;
    __device__ __forceinline__ void mid(f32x4 (&)[2][2][4][2], const Unit&, int, int, int, int) const {}
    __device__ __forceinline__ void operator()(const f32x4 (&acc)[2][2][4][2], const Unit& u, int wr, int wc, int fr, int fq) const {
        const int pn = u.pn; const int row0 = u.pm * BM + wr * 64 + fr;
        if (pn < 16) {
            const int g = pn >> 1;
            bf16_t* base = (bf16_t*)(ws + WS_P + (size_t)g * (32 * MiB)) + (pn & 1) * 256 + wc * 64 + 8 * fq;
            if (g <= 1) {
                const float* nw = (g == 0 ? qnw : knw) + 8 * fq; f32x4 wv[2][2], cs[2][2];
#pragma unroll
                for (int bj = 0; bj < 2; ++bj)
#pragma unroll
                    for (int n = 0; n < 2; ++n) { wv[bj][n] = *(const f32x4*)(nw + 32 * bj + 4 * n); if (g == 0) wv[bj][n] = wv[bj][n] * C2; cs[bj][n] = (f32x4){0.f, 0.f, 0.f, 0.f}; }
#pragma unroll
                for (int ai = 0; ai < 2; ++ai)
#pragma unroll
                    for (int m = 0; m < 4; ++m) { float ss = 0.f;
#pragma unroll
                        for (int bj = 0; bj < 2; ++bj)
#pragma unroll
                            for (int n = 0; n < 2; ++n) { const f32x4 x = acc[ai][bj][m][n]; ss += (x[0] * x[0] + x[1] * x[1]) + (x[2] * x[2] + x[3] * x[3]); }
                        ss += __shfl_xor(ss, 16); ss += __shfl_xor(ss, 32);
                        const float rstd = __builtin_amdgcn_rsqf(ss * (1.0f / 64.0f) + EPS);
                        bf16_t* rowp = base + (size_t)(row0 + ai * HALF + m * 16) * W;
#pragma unroll
                        for (int bj = 0; bj < 2; ++bj) { const f32x4 v0 = acc[ai][bj][m][0] * rstd * wv[bj][0], v1 = acc[ai][bj][m][1] * rstd * wv[bj][1];
                            if (g == 1) { cs[bj][0] += v0; cs[bj][1] += v1; }
                            if (!nostore) { if (NT_QKVZ) st16(rowp + bj * 32, pack8(v0, v1)); else st16p(rowp + bj * 32, pack8(v0, v1)); } } }
                if (g == 1) {
                    float* ks = (float*)(ws + WS_KSUM) + ((size_t)((u.pm >> 3) * NH + (pn & 1) * 4 + wc) * NBLK + (u.pm & 7)) * 64 + 8 * fq;
#pragma unroll
                    for (int bj = 0; bj < 2; ++bj)
#pragma unroll
                        for (int n = 0; n < 2; ++n)
#pragma unroll
                            for (int e = 0; e < 4; ++e) { float x = cs[bj][n][e]; x += __shfl_xor(x, 1); x += __shfl_xor(x, 2); x += __shfl_xor(x, 4); x += __shfl_xor(x, 8);
                                if (fr == 0 && !nostore) atomicAdd(ks + 32 * bj + 4 * n + e, x); }
                }
            } else {
                const bool silu = (g == 3) || (g == 7); const float sc = (g == 4) ? C2 : 1.0f;
#pragma unroll
                for (int ai = 0; ai < 2; ++ai)
#pragma unroll
                    for (int m = 0; m < 4; ++m) { bf16_t* rowp = base + (size_t)(row0 + ai * HALF + m * 16) * W;
#pragma unroll
                        for (int bj = 0; bj < 2; ++bj) { f32x4 v0 = acc[ai][bj][m][0] * sc, v1 = acc[ai][bj][m][1] * sc;
                            if (silu) {
#pragma unroll
                                for (int e = 0; e < 4; ++e) { v0[e] = v0[e] * sigm(v0[e]); v1[e] = v1[e] * sigm(v1[e]); } }
                            if (!nostore) { if (NT_QKVZ) st16(rowp + bj * 32, pack8(v0, v1)); else st16p(rowp + bj * 32, pack8(v0, v1)); } } }
            }
        } else {
            const int gc = 128 * (pn - 16) + 32 * wc + 8 * fq; f32x4 ba[2], bb[2];
#pragma unroll
            for (int n = 0; n < 2; ++n) { ba[n] = *(const f32x4*)(gbias + gc + 4 * n); bb[n] = *(const f32x4*)(gbias + DM + gc + 4 * n); }
            bf16_t* gr = (bf16_t*)(ws + WS_GR) + gc; bf16_t* gbp = (bf16_t*)(ws + WS_GB) + gc;
#pragma unroll
            for (int ai = 0; ai < 2; ++ai)
#pragma unroll
                for (int m = 0; m < 4; ++m) { const size_t ro = (size_t)(row0 + ai * HALF + m * 16) * DM; f32x4 r[2], b[2];
#pragma unroll
                    for (int n = 0; n < 2; ++n)
#pragma unroll
                        for (int e = 0; e < 4; ++e) { const float sa = sigm(acc[ai][0][m][n][e] + ba[n][e]); const float sb = __builtin_fmaxf(sigm(acc[ai][1][m][n][e] + bb[n][e]), 9.5367431640625e-07f);
                            b[n][e] = sb; r[n][e] = sa * __builtin_amdgcn_rcpf(sb); }
                    if (!nostore) { st16(gr + ro, pack8(r[0], r[1])); st16(gbp + ro, pack8(b[0], b[1])); } }
        }
    }
};
struct EpiY {
    static constexpr bool PERM = true, AFTER_DRAIN = false, MIDK = true;
    const bf16_t* GR; const bf16_t* GB; bf16_t* Y; PG8_LAS unsigned* dummy;
    __device__ __forceinline__ void mid(f32x4 (&acc)[2][2][4][2], const Unit& u, int wr, int wc, int fr, int fq) const {
        unsigned lo = (unsigned)(fr * DM + 8 * fq); asm volatile("" : "+v"(lo));
        const bf16_t* p = GR + (size_t)(u.pm * BM + wr * 64) * DM + u.pn * BM + wc * 64 + lo;
#if WARM_GB
        { const bf16_t* q = GB + (size_t)(u.pm * BM + wr * 64) * DM + u.pn * BM + wc * 64 + lo;
#pragma unroll
          for (int ai = 0; ai < 2; ++ai)
#pragma unroll
            for (int m = 0; m < 4; ++m)
#pragma unroll
                for (int bj = 0; bj < 2; ++bj) __builtin_amdgcn_global_load_lds((const unsigned*)(q + (size_t)(ai * HALF + m * 16) * DM + bj * 32), dummy, 16, 0, 0); }
#endif
#pragma unroll
        for (int ai = 0; ai < 2; ++ai)
#pragma unroll
            for (int m = 0; m < 4; ++m) {
#pragma unroll
                for (int bj = 0; bj < 2; ++bj) { const u32x4 w = NT_LOADS ? __builtin_nontemporal_load((const u32x4*)(p + (size_t)(ai * HALF + m * 16) * DM + bj * 32)) : *(const u32x4*)(p + (size_t)(ai * HALF + m * 16) * DM + bj * 32); f32x4 a, b; unpack8(w, a, b);
                    acc[ai][bj][m][0] = acc[ai][bj][m][0] * a; acc[ai][bj][m][1] = acc[ai][bj][m][1] * b; }
                if (EPIY_FENCE && m == 3) asm volatile("" ::: "memory"); }
    }
    __device__ __forceinline__ void operator()(const f32x4 (&acc)[2][2][4][2], const Unit& u, int wr, int wc, int fr, int fq) const {
        unsigned lo = (unsigned)(fr * DM + 8 * fq); asm volatile("" : "+v"(lo));
        const size_t o0 = (size_t)(u.pm * BM + wr * 64) * DM + u.pn * BM + wc * 64 + lo;
#pragma unroll
        for (int ai = 0; ai < 2; ++ai)
#pragma unroll
            for (int m = 0; m < 4; ++m) {
#pragma unroll
                for (int bj = 0; bj < 2; ++bj) { const size_t o = o0 + (size_t)(ai * HALF + m * 16) * DM + bj * 32; const u32x4 w = NT_LOADS ? __builtin_nontemporal_load((const u32x4*)(GB + o)) : *(const u32x4*)(GB + o); f32x4 a, b; unpack8(w, a, b);
                    st16(Y + o, pack8(acc[ai][bj][m][0] * a, acc[ai][bj][m][1] * b)); }
                if (EPIY_FENCE && m == 3) asm volatile("" ::: "memory"); }
    }
};
struct EpiOut {
    static constexpr bool PERM = true, AFTER_DRAIN = false, MIDK = false;
    const float* X; float* OUT;
    __device__ __forceinline__ void mid(f32x4 (&)[2][2][4][2], const Unit&, int, int, int, int) const {}
    __device__ __forceinline__ void operator()(const f32x4 (&acc)[2][2][4][2], const Unit& u, int wr, int wc, int fr, int fq) const {
        const size_t o0 = (size_t)(u.pm * BM + wr * 64 + fr) * DM + u.pn * BM + wc * 64 + 8 * fq;
#pragma unroll
        for (int ai = 0; ai < 2; ++ai)
#pragma unroll
            for (int m = 0; m < 4; ++m) {
#pragma unroll
                for (int bj = 0; bj < 2; ++bj) { const size_t o = o0 + (size_t)(ai * HALF + m * 16) * DM + bj * 32;
                    const f32x4 x0 = NT_LOADS ? __builtin_nontemporal_load((const f32x4*)(X + o)) : *(const f32x4*)(X + o), x1 = NT_LOADS ? __builtin_nontemporal_load((const f32x4*)(X + o + 4)) : *(const f32x4*)(X + o + 4);

#ifdef NT_OUT
                    __builtin_nontemporal_store(x0 + acc[ai][bj][m][0], (f32x4*)(OUT + o)); __builtin_nontemporal_store(x1 + acc[ai][bj][m][1], (f32x4*)(OUT + o + 4)); }
#else
                    *(f32x4*)(OUT + o) = x0 + acc[ai][bj][m][0]; *(f32x4*)(OUT + o + 4) = x1 + acc[ai][bj][m][1]; }
#endif

                if (m == 3) asm volatile("" ::: "memory"); }
    }
};

template <class Epi, class Sched, bool ALIGN_EPI = false, bool SP2 = false>
__device__ __forceinline__ void gemm_phase(PG8_LAS unsigned char* lds, const Gemm g, const Sched& S, const Epi& E) {
    const int tid = threadIdx.x, wid = __builtin_amdgcn_readfirstlane(tid >> 6), lane = tid & 63, wr = wid >> 2, wc = wid & 3, fr = lane & 15, fq = lane >> 4;
    const int K = g.K, nt = K / BK;
    unsigned voffA[2], voffB[2];
#pragma unroll
    for (int i = 0; i < 2; ++i) { int R, C; stage_rc(tid * 16 + i * 8192, R, C); const int Rb = Epi::PERM ? ((R & ~31) + perm32(R & 31)) : R;
        voffA[i] = (unsigned)(R * g.lda + C) * 2u; voffB[i] = (unsigned)(Rb * g.ldb + C) * 2u; }
    const size_t kstep = (size_t)(BK * 2);
    const size_t hA = (size_t)HALF * g.lda * 2, hB = (size_t)HALF * g.ldb * 2;
    const size_t tA = 2 * hA, tB = 2 * hB;
    const unsigned ldsw = (unsigned)wid * 1024u;
    const int aoff = lds_byte(wr * 64 + fr, fq * 8), boff = lds_byte(wc * 32 + fr, fq * 8);
#define PG8_SA(b, h) (((b) * 2 + (h)) * HTB)
#define PG8_SB(b, h) ((4 + (b) * 2 + (h)) * HTB)
#define PG8_STAGE(bufoff, gbase, voff) do { _Pragma("unroll") for (int _i = 0; _i < 2; ++_i) \
        __builtin_amdgcn_global_load_lds((const unsigned*)((const char*)(gbase) + (voff)[_i]), (PG8_LAS unsigned*)(lds + (bufoff) + ldsw + _i * 8192), 16, 0, 0); } while (0)
#define PG8_LDA(dst, b, h) do { _Pragma("unroll") for (int m = 0; m < 4; ++m) _Pragma("unroll") for (int k = 0; k < 2; ++k) dst[m][k] = *(const PG8_LAS bf16x8*)(lds + PG8_SA(b, h) + aoff + m * 2048 + k * 1024); } while (0)
#define PG8_LDB(dst, b, h) do { _Pragma("unroll") for (int n = 0; n < 2; ++n) _Pragma("unroll") for (int k = 0; k < 2; ++k) dst[n][k] = *(const PG8_LAS bf16x8*)(lds + PG8_SB(b, h) + boff + n * 2048 + k * 1024); } while (0)
#define PG8_MMA(ai, bj, At, Bt) do { __builtin_amdgcn_s_setprio(1); _Pragma("unroll") for (int m = 0; m < 4; ++m) _Pragma("unroll") for (int n = 0; n < 2; ++n) _Pragma("unroll") for (int k = 0; k < 2; ++k) \
        acc[ai][bj][m][n] = __builtin_amdgcn_mfma_f32_16x16x32_bf16(Bt[n][k], At[m][k], acc[ai][bj][m][n], 0, 0, 0); __builtin_amdgcn_s_setprio(0); } while (0)
#define PG8_WAIT_V(n) asm volatile("s_waitcnt vmcnt(" #n ")" ::: "memory")
#define PG8_WAIT_L(n) asm volatile("s_waitcnt lgkmcnt(" #n ")" ::: "memory")
#define PG8_BAR __builtin_amdgcn_s_barrier()
#define PG8_SCHED __builtin_amdgcn_sched_barrier(0)
    Unit cur, nxt; int ui = 0;
    if (!S.next(0, cur)) return;
    f32x4 acc[2][2][4][2];
#pragma unroll
    for (int a = 0; a < 2; ++a)
#pragma unroll
        for (int b = 0; b < 2; ++b)
#pragma unroll
            for (int m = 0; m < 4; ++m)
#pragma unroll
                for (int n = 0; n < 2; ++n) acc[a][b][m][n] = (f32x4){0.f, 0.f, 0.f, 0.f};
    bf16x8 At[4][2], B0[2][2], B1[2][2];
    const char* cA = (const char*)g.A + (size_t)cur.pm * tA; const char* cB = (const char*)g.Bt + (size_t)cur.pn * tB;
    S.a_ready(cur);
    if constexpr (SP2) {
        PG8_STAGE(PG8_SB(0, 0), cB, voffB); PG8_STAGE(PG8_SB(0, 1), cB + hB, voffB); PG8_STAGE(PG8_SA(0, 0), cA, voffA); PG8_STAGE(PG8_SA(0, 1), cA + hA, voffA);
        if (wr == 1) PG8_BAR;
        PG8_WAIT_V(2); PG8_BAR;
        PG8_STAGE(PG8_SB(1, 0), cB + kstep, voffB); PG8_STAGE(PG8_SA(1, 0), cA + kstep, voffA); PG8_STAGE(PG8_SB(1, 1), cB + hB + kstep, voffB);
        PG8_WAIT_V(6); PG8_BAR;
    } else {
        PG8_STAGE(PG8_SB(0, 0), cB, voffB); PG8_STAGE(PG8_SA(0, 0), cA, voffA); PG8_STAGE(PG8_SB(0, 1), cB + hB, voffB); PG8_STAGE(PG8_SA(0, 1), cA + hA, voffA);
        if (wr == 1) PG8_BAR;
        PG8_WAIT_V(4); PG8_BAR;
        PG8_STAGE(PG8_SB(1, 0), cB + kstep, voffB); PG8_STAGE(PG8_SA(1, 0), cA + kstep, voffA); PG8_STAGE(PG8_SB(1, 1), cB + hB + kstep, voffB);
        PG8_WAIT_V(6); PG8_BAR;
    }
    for (;;) {
        const bool has_next = S.next(ui + 1, nxt);
        const char* nA = has_next ? (const char*)g.A + (size_t)nxt.pm * tA : cA; const char* nB = has_next ? (const char*)g.Bt + (size_t)nxt.pn * tB : cB;
        constexpr int NH = Epi::MIDK ? 2 : 1;
#pragma unroll 1
        for (int hh = 0; hh < NH; ++hh) {
        if constexpr (Epi::MIDK) { if (hh == 1) { int fr_ = fr, fq_ = fq; asm volatile("" : "+v"(fr_), "+v"(fq_)); E.mid(acc, cur, wr, wc, fr_, fq_); } }
#pragma unroll 1
        for (int t = hh * (nt / NH); t < (hh + 1) * (nt / NH); t += 2) {
            const bool last = (t == nt - 2);
            const char* a1 = cA + (size_t)(t + 1) * kstep;
            const char* a2 = last ? nA : cA + (size_t)(t + 2) * kstep; const char* b2 = last ? nB : cB + (size_t)(t + 2) * kstep;
            const char* a3 = a2 + kstep; const char* b3 = b2 + kstep;
            if (last && has_next) S.a_ready(nxt);
            if constexpr (SP2) {
            PG8_LDB(B0, 0, 0); PG8_LDB(B1, 0, 1); PG8_SCHED; PG8_LDA(At, 0, 0); PG8_STAGE(PG8_SA(1, 1), a1 + hA, voffA);
            PG8_WAIT_V(8); PG8_WAIT_L(0); PG8_BAR; PG8_MMA(0, 0, At, B0); PG8_MMA(0, 1, At, B1); PG8_BAR; PG8_SCHED;
            PG8_LDA(At, 0, 1); PG8_STAGE(PG8_SB(0, 0), b2, voffB); PG8_STAGE(PG8_SB(0, 1), b2 + hB, voffB); PG8_STAGE(PG8_SA(0, 0), a2, voffA);
            PG8_WAIT_V(8); PG8_WAIT_L(0); PG8_BAR; PG8_MMA(1, 0, At, B0); PG8_MMA(1, 1, At, B1); PG8_BAR; PG8_SCHED;
            PG8_LDB(B0, 1, 0); PG8_LDB(B1, 1, 1); PG8_SCHED; PG8_LDA(At, 1, 0); PG8_STAGE(PG8_SA(0, 1), a2 + hA, voffA);
            PG8_WAIT_V(8); PG8_WAIT_L(0); PG8_BAR; PG8_MMA(0, 0, At, B0); PG8_MMA(0, 1, At, B1); PG8_BAR; PG8_SCHED;
            PG8_LDA(At, 1, 1); PG8_STAGE(PG8_SB(1, 0), b3, voffB); PG8_STAGE(PG8_SB(1, 1), b3 + hB, voffB); PG8_STAGE(PG8_SA(1, 0), a3, voffA);
            PG8_WAIT_V(8); PG8_WAIT_L(0); PG8_BAR; PG8_MMA(1, 0, At, B0); PG8_MMA(1, 1, At, B1); PG8_BAR; PG8_SCHED;
            } else {
            PG8_LDB(B0, 0, 0); PG8_SCHED; PG8_LDA(At, 0, 0); PG8_STAGE(PG8_SA(1, 1), a1 + hA, voffA);
            PG8_WAIT_L(8); PG8_BAR; PG8_WAIT_L(0); PG8_MMA(0, 0, At, B0); PG8_BAR; PG8_SCHED;
            PG8_LDB(B1, 0, 1); PG8_STAGE(PG8_SB(0, 0), b2, voffB);
            PG8_BAR; PG8_WAIT_L(0); PG8_MMA(0, 1, At, B1); PG8_BAR;
            PG8_LDA(At, 0, 1); PG8_STAGE(PG8_SA(0, 0), a2, voffA);
            PG8_BAR; PG8_WAIT_L(0); PG8_MMA(1, 0, At, B0); PG8_BAR; PG8_SCHED;
            PG8_STAGE(PG8_SB(0, 1), b2 + hB, voffB);
            PG8_WAIT_V(6); PG8_BAR; PG8_MMA(1, 1, At, B1); PG8_BAR;
            PG8_LDB(B0, 1, 0); PG8_SCHED; PG8_LDA(At, 1, 0); PG8_STAGE(PG8_SA(0, 1), a2 + hA, voffA);
            PG8_WAIT_L(8); PG8_BAR; PG8_WAIT_L(0); PG8_MMA(0, 0, At, B0); PG8_BAR; PG8_SCHED;
            PG8_LDB(B1, 1, 1); PG8_STAGE(PG8_SB(1, 0), b3, voffB);
            PG8_BAR; PG8_WAIT_L(0); PG8_MMA(0, 1, At, B1); PG8_BAR;
            PG8_LDA(At, 1, 1); PG8_STAGE(PG8_SA(1, 0), a3, voffA);
            PG8_BAR; PG8_WAIT_L(0); PG8_MMA(1, 0, At, B0); PG8_BAR; PG8_SCHED;
            PG8_STAGE(PG8_SB(1, 1), b3 + hB, voffB);
            PG8_WAIT_V(6); PG8_BAR; PG8_MMA(1, 1, At, B1); PG8_BAR;
            }
        }
        }
        if constexpr (ALIGN_EPI) { if (wr == 0) PG8_BAR; }
        if constexpr (!Epi::AFTER_DRAIN) { int fr_ = fr, fq_ = fq; asm volatile("" : "+v"(fr_), "+v"(fq_));
            E(acc, cur, wr, wc, fr_, fq_);
#ifdef EPI2
            asm volatile("" : "+v"(fr_), "+v"(fq_)); E(acc, cur, wr, wc, fr_, fq_);
#endif
            S.done(cur); }
        if (!has_next) break;
#pragma unroll
        for (int a = 0; a < 2; ++a)
#pragma unroll
            for (int b = 0; b < 2; ++b)
#pragma unroll
                for (int m = 0; m < 4; ++m)
#pragma unroll
                    for (int n = 0; n < 2; ++n) acc[a][b][m][n] = (f32x4){0.f, 0.f, 0.f, 0.f};
        cur = nxt; cA = nA; cB = nB; ++ui;
        if constexpr (ALIGN_EPI) { if (wr == 1) PG8_BAR; }
    }
    PG8_WAIT_V(0);
    if constexpr (!ALIGN_EPI) { if (wr == 0) PG8_BAR; }
    PG8_BAR;
    if constexpr (Epi::AFTER_DRAIN) { E.fused(acc, cur, wr, wc, fr, fq, lds, wid, lane); S.done(cur); }
#undef PG8_SA
#undef PG8_SB
#undef PG8_STAGE
#undef PG8_LDA
#undef PG8_LDB
#undef PG8_MMA
#undef PG8_WAIT_V
#undef PG8_WAIT_L
#undef PG8_BAR
#undef PG8_SCHED
}
}

#ifndef PG8_SP2
#define PG8_SP2 true
#endif
#ifndef PG8_ALIGN
#define PG8_ALIGN true
#endif

namespace attn {
using bf16 = unsigned short;
using bf16x8 = __attribute__((ext_vector_type(8))) short;
using f16x8 = __attribute__((ext_vector_type(8))) _Float16;
using s16x4 = __attribute__((ext_vector_type(4))) short;
using f32x16 = __attribute__((ext_vector_type(16))) float;
using f32x4 = __attribute__((ext_vector_type(4))) float;
using u32x4 = __attribute__((ext_vector_type(4))) unsigned;
typedef LAS const char* lds_cptr;
constexpr int NW = 8, QBLK = 32, QB = 256, KVBLK = 64, PITCH = W, OPITCH = DM;
constexpr int SLOTB = 8192;
constexpr int NSLOT = 3;
constexpr int LDS_K = 0, LDS_V = NSLOT * SLOTB, LDS_WS = 2 * NSLOT * SLOTB, LDS_TAB = LDS_WS + NW * 256, LDS_FLAG = LDS_TAB + 1024, LDS_OST = LDS_FLAG + 1024, LDS_ZST = LDS_OST + NW * 4096, LDS_BYTES = LDS_ZST + NW * 4096;
__device__ __forceinline__ int crow(int r, int hi) { return (r & 3) + 8 * (r >> 2) + 4 * hi; }
#define SBAR() __builtin_amdgcn_sched_barrier(0)
#ifdef UT_PROBE
#ifndef UT_UNIT
#define UT_UNIT 0
#endif
#define UTS(k) do { if (blockIdx.x == 0 && threadIdx.x == 0) { volatile LAS unsigned long long* u_ = (volatile LAS unsigned long long*)(shm + 132096); if (u_[7] == (unsigned long long)UT_UNIT) u_[k] = __builtin_amdgcn_s_memrealtime(); if ((k) == 4) u_[7] = u_[7] + 1ull; } } while (0)
#else
#define UTS(k) do {} while (0)
#endif
#define WAIT_BAR0() asm volatile("s_waitcnt vmcnt(0) lgkmcnt(0)\n\ts_barrier" ::: "memory")
__device__ __forceinline__ void glds16(const void* gsrc, unsigned lds_dst) { unsigned keep;
    asm volatile("s_mov_b32 %0, m0\n\ts_mov_b32 m0, %2\n\ts_nop 0\n\tglobal_load_lds_dwordx4 %1, off\n\ts_mov_b32 m0, %0" : "=&s"(keep) : "v"(gsrc), "s"(lds_dst) : "memory"); }
__device__ __forceinline__ unsigned cvtpk(float lo, float hi) { typedef float f2 __attribute__((ext_vector_type(2))); typedef __bf16 b2 __attribute__((ext_vector_type(2))); f2 v = {lo, hi}; b2 b = __builtin_convertvector(v, b2); return __builtin_bit_cast(unsigned, b); }
__device__ __forceinline__ unsigned cvtpk_h(float lo, float hi) { typedef float f2 __attribute__((ext_vector_type(2))); typedef _Float16 h2 __attribute__((ext_vector_type(2))); f2 v = {lo, hi}; h2 b = __builtin_convertvector(v, h2); return __builtin_bit_cast(unsigned, b); }
#define MX3(a, b, c) __builtin_fmaxf(__builtin_fmaxf((a), (b)), (c))
__device__ __forceinline__ float rowmax(const f32x16& p0, const f32x16& p1) {
    float a = MX3(p0[0], p0[1], p1[0]), b = MX3(p0[2], p0[3], p1[1]); a = MX3(a, p1[2], p1[3]);
#pragma unroll
    for (int r = 4; r < 16; r += 4) { a = MX3(a, p0[r], p0[r + 1]); b = MX3(b, p0[r + 2], p0[r + 3]); a = MX3(a, p1[r], p1[r + 1]); b = MX3(b, p1[r + 2], p1[r + 3]); }
    float m = __builtin_fmaxf(a, b); auto rr = __builtin_amdgcn_permlane32_swap(__float_as_uint(m), __float_as_uint(m), false, false);
    return __builtin_fmaxf(__uint_as_float(rr[0]), __uint_as_float(rr[1])); }
__device__ __forceinline__ float lowhalf(float v) { auto rr = __builtin_amdgcn_permlane32_swap(__float_as_uint(v), __float_as_uint(v), false, false); return __uint_as_float(rr[0]); }
__device__ __forceinline__ float fadd_s(float a, float b) { float r; asm("v_add_f32_e32 %0, %1, %2" : "=v"(r) : "v"(a), "v"(b)); return r; }
__device__ __forceinline__ float fsub_s(float a, float b) { float r; asm("v_sub_f32_e32 %0, %1, %2" : "=v"(r) : "v"(a), "v"(b)); return r; }
__device__ __forceinline__ unsigned cvtpk_s(float lo, float hi) { return cvtpk(lo, hi); }
typedef short v4i16_t __attribute__((ext_vector_type(4)));
__device__ __forceinline__ void kload8(bf16x8* kf, lds_cptr kp) {
    kf[0] = *(const LAS bf16x8*)(kp);        kf[1] = *(const LAS bf16x8*)(kp + 512);
    kf[2] = *(const LAS bf16x8*)(kp + 2048); kf[3] = *(const LAS bf16x8*)(kp + 2560);
    kf[4] = *(const LAS bf16x8*)(kp + 4096); kf[5] = *(const LAS bf16x8*)(kp + 4608);
    kf[6] = *(const LAS bf16x8*)(kp + 6144); kf[7] = *(const LAS bf16x8*)(kp + 6656); }
__device__ __forceinline__ void kload2(bf16x8* kf, lds_cptr kp, int j) { kf[2 * j] = *(const LAS bf16x8*)(kp + j * 2048); kf[2 * j + 1] = *(const LAS bf16x8*)(kp + j * 2048 + 512); }
__device__ __forceinline__ s16x4 vtr(lds_cptr p) { return __builtin_bit_cast(s16x4, __builtin_amdgcn_ds_read_tr16_b64_v4i16((LAS v4i16_t*)p)); }
__device__ __forceinline__ void qkt(f32x16& p0, f32x16& p1, lds_cptr Kslot, const bf16x8* qr, const f32x16& c0, int r32, int hi) {
    const lds_cptr kb = Kslot + hi * 1024 + r32 * 16;
#pragma unroll
    for (int d0 = 0; d0 < 4; ++d0) {
        const bf16x8 b0 = *(const LAS bf16x8*)(kb + d0 * 2048);
        const bf16x8 b1 = *(const LAS bf16x8*)(kb + d0 * 2048 + 512);
        if (d0 == 0) { p0 = __builtin_amdgcn_mfma_f32_32x32x16_bf16(b0, qr[0], c0, 0, 0, 0); p1 = __builtin_amdgcn_mfma_f32_32x32x16_bf16(b1, qr[0], c0, 0, 0, 0); }
        else { p0 = __builtin_amdgcn_mfma_f32_32x32x16_bf16(b0, qr[d0], p0, 0, 0, 0); p1 = __builtin_amdgcn_mfma_f32_32x32x16_bf16(b1, qr[d0], p1, 0, 0, 0); } }
}
__device__ __forceinline__ void pv(f32x16* o, int vb, bf16x8 pa0, bf16x8 pa1, bf16x8 pa2, bf16x8 pa3) {
#pragma unroll
    for (int d0 = 0; d0 < 2; ++d0) { s16x4 lo[4], hi[4];
#pragma unroll
        for (int ks = 0; ks < 4; ++ks) {
            asm volatile("ds_read_b64_tr_b16 %0,%1 offset:%c2" : "=&v"(lo[ks]) : "v"(vb), "i"(d0 * 4096 + ks * 1024) : "memory");
            asm volatile("ds_read_b64_tr_b16 %0,%1 offset:%c2" : "=&v"(hi[ks]) : "v"(vb), "i"(d0 * 4096 + ks * 1024 + 512) : "memory"); }
        asm volatile("s_waitcnt lgkmcnt(0)" ::: "memory"); SBAR();
#define PK(k) (bf16x8){lo[k][0], lo[k][1], lo[k][2], lo[k][3], hi[k][0], hi[k][1], hi[k][2], hi[k][3]}
        o[d0] = __builtin_amdgcn_mfma_f32_32x32x16_bf16(pa0, PK(0), o[d0], 0, 0, 0);
        o[d0] = __builtin_amdgcn_mfma_f32_32x32x16_bf16(pa1, PK(1), o[d0], 0, 0, 0);
        o[d0] = __builtin_amdgcn_mfma_f32_32x32x16_bf16(pa2, PK(2), o[d0], 0, 0, 0);
        o[d0] = __builtin_amdgcn_mfma_f32_32x32x16_bf16(pa3, PK(3), o[d0], 0, 0, 0);
#undef PK
    }
}
#define PKW(P, B) cvtpk(P[B], P[B + 1])
__device__ __forceinline__ void store_gated(const f32x16* o, const float* rsc  , LAS char* stage, const u32x4* zr  , bf16* Ow, int lane, int r32, int hi) {
    LAS bf16* stg = (LAS bf16*)stage;
#pragma unroll
    for (int r = 0; r < 16; ++r) { const int orow = crow(r, hi); const float s = rsc ? rsc[r] : 1.0f;
#pragma unroll
        for (int d0 = 0; d0 < 2; ++d0) { const float v = o[d0][r] * s; const unsigned u = cvtpk(v, v); stg[orow * 64 + d0 * 32 + r32] = (bf16)(u & 0xffffu); } }
    asm volatile("s_waitcnt lgkmcnt(0)" ::: "memory");
#pragma unroll
    for (int i = 0; i < 4; ++i) { const int row = i * 8 + (lane >> 3), ch = lane & 7; const u32x4 v = *(const LAS u32x4*)(stg + row * 64 + ch * 8); const u32x4 z = zr[i];
        u32x4 w;
#pragma unroll
        for (int k = 0; k < 4; ++k) { const float a0 = __uint_as_float(v[k] << 16) * __uint_as_float(z[k] << 16), a1 = __uint_as_float(v[k] & 0xffff0000u) * __uint_as_float(z[k] & 0xffff0000u); w[k] = cvtpk(a0, a1); }
        __builtin_nontemporal_store(w, (u32x4*)(Ow + (size_t)row * OPITCH + ch * 8)); }
}

__device__ __forceinline__ void moba_tables(LAS float* tabs, const float* rel_bias  , int tid) {
    for (int e = tid; e < NH * 130; e += NW * 64) { const int hh = e / 130, i = e % 130; tabs[hh * 132 + i] = (i == 0) ? -1e30f : (i < 129 ? (rel_bias[hh * 32 + T5B[i - 1]] - rel_bias[hh * 32 + 31]) * LOG2E : 0.f); }
}
__device__ __forceinline__ unsigned moba_select(const float* ksum, const bf16x8* qr, int qb, int r32, int hi) {
    unsigned selmask = 0u;
        f32x16 g = f32x16{};
#pragma unroll
        for (int d0 = 0; d0 < 4; ++d0) { const float* kp = ksum + (r32 & 7) * 64 + d0 * 16 + hi * 8; f32x4 x0 = *(const f32x4*)kp, x1 = *(const f32x4*)(kp + 4);
            if (r32 >= 8) { x0 = (f32x4){0.f, 0.f, 0.f, 0.f}; x1 = x0; }
            u32x4 wh, wl; f32x4 y0, y1;
            wh.x = cvtpk(x0[0], x0[1]); wh.y = cvtpk(x0[2], x0[3]); wh.z = cvtpk(x1[0], x1[1]); wh.w = cvtpk(x1[2], x1[3]);
            y0[0] = x0[0] - __uint_as_float(wh.x << 16); y0[1] = x0[1] - __uint_as_float(wh.x & 0xffff0000u); y0[2] = x0[2] - __uint_as_float(wh.y << 16); y0[3] = x0[3] - __uint_as_float(wh.y & 0xffff0000u);
            y1[0] = x1[0] - __uint_as_float(wh.z << 16); y1[1] = x1[1] - __uint_as_float(wh.z & 0xffff0000u); y1[2] = x1[2] - __uint_as_float(wh.w << 16); y1[3] = x1[3] - __uint_as_float(wh.w & 0xffff0000u);
            wl.x = cvtpk(y0[0], y0[1]); wl.y = cvtpk(y0[2], y0[3]); wl.z = cvtpk(y1[0], y1[1]); wl.w = cvtpk(y1[2], y1[3]);
            g = __builtin_amdgcn_mfma_f32_32x32x16_bf16(__builtin_bit_cast(bf16x8, wh), qr[d0], g, 0, 0, 0);
            g = __builtin_amdgcn_mfma_f32_32x32x16_bf16(__builtin_bit_cast(bf16x8, wl), qr[d0], g, 0, 0, 0); }
        float G[8];
#pragma unroll
        for (int r = 0; r < 4; ++r) { auto rr = __builtin_amdgcn_permlane32_swap(__float_as_uint(g[r]), __float_as_uint(g[r]), false, false); G[r] = __uint_as_float(rr[0]); G[4 + r] = __uint_as_float(rr[1]); }
#pragma unroll
        for (int n = 0; n < 8; ++n) { int cnt = 0;
#pragma unroll
            for (int m = 0; m < 8; ++m) cnt += (m < qb) && ((G[m] > G[n]) || (G[m] == G[n] && m < n));
            if (n < qb && cnt < TOPK) selmask |= 1u << n; }
    return selmask;
}

__device__ __forceinline__ void load_gate(u32x4* zr, const bf16* Zw, int lane) {
#pragma unroll
    for (int i = 0; i < 4; ++i) zr[i] = *(const u32x4*)(Zw + (size_t)(i * 8 + (lane >> 3)) * PITCH + (lane & 7) * 8);
}
__device__ __forceinline__ void warm_rows(const bf16* base  , long row0, int ninstr, unsigned dummy_lds, int wid, int lane) {
    const bf16* p = base + (row0 + (long)wid * 8 * ninstr + (lane >> 3)) * PITCH + (lane & 7) * 8;
    for (int i = 0; i < ninstr; ++i) glds16(p + (long)(8 * i) * PITCH, dummy_lds);
}
template <int THRL>
__device__ __forceinline__ void moba_unit(int b, int h, int qb, const bf16* Q, const bf16* __restrict__ K, const bf16* __restrict__ V, const bf16* Z, bf16* O, const float* ksum, const float* relb, LAS char* lds) {
    int tid_ = threadIdx.x; asm volatile("" : "+v"(tid_));
    const int tid = tid_, lane = tid & 63, r32 = lane & 31, hi = lane >> 5; const int wid = __builtin_amdgcn_readfirstlane(tid >> 6);
    const long rowbase = (long)b * SEQ; const int q0 = qb * QB, wq0 = q0 + wid * QBLK;
    const bf16* Qw = Q + (rowbase + wq0) * PITCH + h * HD;
    const bf16* Kh = K + rowbase * PITCH + h * HD; const bf16* Vh = V + rowbase * PITCH + h * HD;
    const unsigned lds0 = (unsigned)(uintptr_t)lds;
    LAS float* wsf = (LAS float*)(lds + LDS_WS) + wid * 64; LAS float* tab = (LAS float*)(lds + LDS_TAB);
    const bf16* ksrc = Kh + (long)lane * PITCH + wid * 8;
    const bf16* vsrc = Vh + (long)(16 * (wid & 3) + (lane >> 2)) * PITCH + (wid >> 2) * 32 + (lane & 3) * 8;
    const unsigned kdst = lds0 + LDS_K + wid * 1024, vdst = lds0 + LDS_V + wid * 1024;
#define DMA_K(t, slot) glds16(ksrc + (long)(t) * KVBLK * PITCH, (unsigned)__builtin_amdgcn_readfirstlane(kdst + (slot)))
#define DMA_V(t, slot) glds16(vsrc + (long)(t) * KVBLK * PITCH, (unsigned)__builtin_amdgcn_readfirstlane(vdst + (slot)))
    const int vb0 = (int)(lds0 + LDS_V) + ((lane >> 4) & 1) * 32 + (lane & 3) * 8 + (4 * hi + ((lane & 15) >> 2)) * 64;
    const lds_cptr Kbase = (lds_cptr)lds + LDS_K;
    if (tid <= 128) tab[tid] = tid < 128 ? (relb[T5B[tid]] - relb[31]) * LOG2E : 0.f;
    DMA_K(0, 0); DMA_V(0, 0);
    bf16x8 qr[4];
#pragma unroll
    for (int d0 = 0; d0 < 4; ++d0) qr[d0] = *reinterpret_cast<const bf16x8*>(&Qw[(long)r32 * PITCH + d0 * 16 + hi * 8]);
    const unsigned selmask = (qb <= TOPK) ? ((1u << qb) - 1u) : moba_select(ksum, qr, qb, r32, hi);
    float mhat = 0.f, l_reg = 0.f; bool set = false; f32x16 o[2]; o[0] = f32x16{}; o[1] = f32x16{};
    const int NT = (q0 + QB) / KVBLK;
    for (int t = 0; t < NT; ++t) {
        const int slot = (t & 1) * SLOTB;
        WAIT_BAR0();
        if (t + 1 < NT) { DMA_K(t + 1, slot ^ SLOTB); DMA_V(t + 1, slot ^ SLOTB); }
        const int key0 = t * KVBLK;
        if (key0 > wq0 + QBLK - 1) continue;
        const int blk = t >> 2; const bool on = (blk == qb) || ((selmask >> blk) & 1u);
        const float nm = on ? -mhat : -1e30f; f32x16 negm;
#pragma unroll
        for (int r = 0; r < 16; ++r) negm[r] = nm;
        f32x16 p0, p1; qkt(p0, p1, Kbase + slot, qr, negm, r32, hi);
        if (wq0 - (key0 + KVBLK - 1) < 128) {
            const int dbase = wq0 + r32 - key0 - 4 * hi;
#pragma unroll
            for (int r = 0; r < 16; ++r) { const int d0_ = dbase - ((r & 3) + 8 * (r >> 2)), d1_ = d0_ - 32;
                const int i0 = d0_ < 0 ? 0 : (d0_ > 128 ? 128 : d0_), i1 = d1_ < 0 ? 0 : (d1_ > 128 ? 128 : d1_);
                p0[r] = d0_ < 0 ? -1e30f : p0[r] + tab[i0]; p1[r] = d1_ < 0 ? -1e30f : p1[r] + tab[i1]; }
        }
        const float rm = rowmax(p0, p1);
        const bool live = rm > -1e29f; const bool need = live && (!set || rm > (float)THRL);
        if (__any(need)) {
            const float dl = live ? (set ? __builtin_fmaxf(rm, 0.f) : rm) : 0.f; const float f = set ? __builtin_amdgcn_exp2f(-dl) : 1.0f;
            mhat += dl; set = set || live; l_reg *= f;
#pragma unroll
            for (int r = 0; r < 16; ++r) { p0[r] -= dl; p1[r] -= dl; }
            if (hi == 0) wsf[r32] = f;
            asm volatile("s_waitcnt lgkmcnt(0)" ::: "memory");
#pragma unroll
            for (int d_ = 0; d_ < 2; ++d_)
#pragma unroll
                for (int r = 0; r < 16; ++r) o[d_][r] *= wsf[crow(r, hi)];
            asm volatile("s_waitcnt lgkmcnt(0)" ::: "memory");
        }
        float sacc = 0.f;
#pragma unroll
        for (int r = 0; r < 16; ++r) { p0[r] = __builtin_amdgcn_exp2f(p0[r]); p1[r] = __builtin_amdgcn_exp2f(p1[r]); sacc += p0[r] + p1[r]; }
        l_reg += sacc;
        u32x4 pw0 = (u32x4){PKW(p0, 0), PKW(p0, 2), PKW(p0, 4), PKW(p0, 6)}, pw1 = (u32x4){PKW(p0, 8), PKW(p0, 10), PKW(p0, 12), PKW(p0, 14)};
        u32x4 pw2 = (u32x4){PKW(p1, 0), PKW(p1, 2), PKW(p1, 4), PKW(p1, 6)}, pw3 = (u32x4){PKW(p1, 8), PKW(p1, 10), PKW(p1, 12), PKW(p1, 14)};
        pv(o, vb0 + slot, __builtin_bit_cast(bf16x8, pw0), __builtin_bit_cast(bf16x8, pw1), __builtin_bit_cast(bf16x8, pw2), __builtin_bit_cast(bf16x8, pw3));
    }
    { auto rr = __builtin_amdgcn_permlane32_swap(__float_as_uint(l_reg), __float_as_uint(l_reg), false, false); l_reg = __uint_as_float(rr[0]) + __uint_as_float(rr[1]); }
    if (hi == 0) wsf[32 + r32] = l_reg; asm volatile("s_waitcnt lgkmcnt(0)" ::: "memory");
    float rli[16];
#pragma unroll
    for (int r = 0; r < 16; ++r) rli[r] = __builtin_amdgcn_rcpf(wsf[32 + crow(r, hi)]);
    { u32x4 zr[4]; load_gate(zr, Z + (rowbase + wq0) * PITCH + h * HD, lane); store_gated(o, rli, lds + LDS_OST + wid * 4096, zr, O + (rowbase + wq0) * OPITCH + h * HD, lane, r32, hi); }
    asm volatile("s_waitcnt vmcnt(0) lgkmcnt(0)\n\ts_barrier" ::: "memory");
#undef DMA_K
#undef DMA_V
}

__device__ __forceinline__ void sb_unit(int b, int h, int qb, const bf16* Q, const bf16* __restrict__ K, const bf16* __restrict__ V, const bf16* Z, bf16* O, LAS char* lds) {
    int tid_ = threadIdx.x; asm volatile("" : "+v"(tid_));
    const int tid = tid_, lane = tid & 63, r32 = lane & 31, hi = lane >> 5; const int wid = __builtin_amdgcn_readfirstlane(tid >> 6);
    const long rowbase = (long)b * SEQ; const int q0 = qb * QB, wq0 = q0 + wid * QBLK;
    const bf16* Qw = Q + (rowbase + wq0) * PITCH + h * HD;
    const bf16* Kh = K + rowbase * PITCH + h * HD; const bf16* Vh = V + rowbase * PITCH + h * HD;
    const unsigned lds0 = (unsigned)(uintptr_t)lds;
    volatile LAS unsigned* flg = (volatile LAS unsigned*)(lds + LDS_FLAG);
    const bf16* ksrc = Kh + (long)lane * PITCH + wid * 8;
    const bf16* vsrc = Vh + (long)(16 * (wid & 3) + (lane >> 2)) * PITCH + (wid >> 2) * 32 + (lane & 3) * 8;
    const unsigned kdst = lds0 + LDS_K + wid * 1024, vdst = lds0 + LDS_V + wid * 1024;
#define DMA_K(t, slot) glds16(ksrc + (long)(t) * KVBLK * PITCH, (unsigned)__builtin_amdgcn_readfirstlane(kdst + (slot)))
#define DMA_V(t, slot) glds16(vsrc + (long)(t) * KVBLK * PITCH, (unsigned)__builtin_amdgcn_readfirstlane(vdst + (slot)))
    const int vb0 = (int)(lds0 + LDS_V) + ((lane >> 4) & 1) * 32 + (lane & 3) * 8 + (4 * hi + ((lane & 15) >> 2)) * 64;
    const lds_cptr Kbase = (lds_cptr)lds + LDS_K;
    const int NT = (q0 + QB) / KVBLK;
    if (tid < 16) flg[tid] = 0u;
    DMA_K(NT - 1, 0); DMA_V(NT - 1, 0);
    bf16x8 qr[4];
#pragma unroll
    for (int d0 = 0; d0 < 4; ++d0) qr[d0] = *reinterpret_cast<const bf16x8*>(&Qw[(long)r32 * PITCH + d0 * 16 + hi * 8]);
    f16x8 tA[2], ones;
#pragma unroll
    for (int s_ = 0; s_ < 2; ++s_)
#pragma unroll
        for (int jj = 0; jj < 8; ++jj) { const int key = 16 * s_ + 8 * (jj >> 2) + 4 * hi + (jj & 3); tA[s_][jj] = (key >= r32) ? (_Float16)1.0f : (_Float16)0.0f; }
#pragma unroll
    for (int jj = 0; jj < 8; ++jj) ones[jj] = (_Float16)1.0f;
    float carry = 0.f; bool done = false; f32x16 o[2]; o[0] = f32x16{}; o[1] = f32x16{};
    const f32x16 zero16 = f32x16{};
    for (int i = 0; i < NT; ++i) {
        const int t = NT - 1 - i, slot = (i & 1) * SLOTB;
        WAIT_BAR0();
        { volatile LAS unsigned* fr_ = flg + ((i & 1) ^ 1) * 8;
          const unsigned a = fr_[0] & fr_[1] & fr_[2] & fr_[3] & fr_[4] & fr_[5] & fr_[6] & fr_[7]; if (a != 0u) break; }
        if (t > 0) { DMA_K(t - 1, slot ^ SLOTB); DMA_V(t - 1, slot ^ SLOTB); }
        const int key0 = t * KVBLK;
        if (!(done || key0 > wq0 + QBLK - 1)) {
        f32x16 z0, z1; qkt(z0, z1, Kbase + slot, qr, zero16, r32, hi);
        const bool band = (key0 + KVBLK - 1 >= wq0);
        const int dbase = wq0 + r32 - key0 - 4 * hi;
        f32x16 l0, l1;
#pragma unroll
        for (int r = 0; r < 16; ++r) { const int d0_ = dbase - ((r & 3) + 8 * (r >> 2)), d1_ = d0_ - 32;
            float a = __builtin_fmaxf(z0[r], 0.f) + __builtin_amdgcn_logf(1.0f + __builtin_amdgcn_exp2f(-__builtin_fabsf(z0[r])));
            float c = __builtin_fmaxf(z1[r], 0.f) + __builtin_amdgcn_logf(1.0f + __builtin_amdgcn_exp2f(-__builtin_fabsf(z1[r])));
            if (band) { a = d0_ > 0 ? a : 0.f; c = d1_ > 0 ? c : 0.f; }
            l0[r] = a; l1[r] = c; }
        u32x4 lf0 = (u32x4){cvtpk_h(l0[0], l0[1]), cvtpk_h(l0[2], l0[3]), cvtpk_h(l0[4], l0[5]), cvtpk_h(l0[6], l0[7])}, lf1 = (u32x4){cvtpk_h(l0[8], l0[9]), cvtpk_h(l0[10], l0[11]), cvtpk_h(l0[12], l0[13]), cvtpk_h(l0[14], l0[15])};
        u32x4 lf2 = (u32x4){cvtpk_h(l1[0], l1[1]), cvtpk_h(l1[2], l1[3]), cvtpk_h(l1[4], l1[5]), cvtpk_h(l1[6], l1[7])}, lf3 = (u32x4){cvtpk_h(l1[8], l1[9]), cvtpk_h(l1[10], l1[11]), cvtpk_h(l1[12], l1[13]), cvtpk_h(l1[14], l1[15])};
        f32x16 ct;
#pragma unroll
        for (int r = 0; r < 16; ++r) ct[r] = carry;
        f32x16 i1 = __builtin_amdgcn_mfma_f32_32x32x16_f16(tA[0], __builtin_bit_cast(f16x8, lf2), ct, 0, 0, 0);
        i1 = __builtin_amdgcn_mfma_f32_32x32x16_f16(tA[1], __builtin_bit_cast(f16x8, lf3), i1, 0, 0, 0);
        f32x16 i0 = __builtin_amdgcn_mfma_f32_32x32x16_f16(ones, __builtin_bit_cast(f16x8, lf2), ct, 0, 0, 0);
        i0 = __builtin_amdgcn_mfma_f32_32x32x16_f16(ones, __builtin_bit_cast(f16x8, lf3), i0, 0, 0, 0);
        i0 = __builtin_amdgcn_mfma_f32_32x32x16_f16(tA[0], __builtin_bit_cast(f16x8, lf0), i0, 0, 0, 0);
        i0 = __builtin_amdgcn_mfma_f32_32x32x16_f16(tA[1], __builtin_bit_cast(f16x8, lf1), i0, 0, 0, 0);
#pragma unroll
        for (int r = 0; r < 16; ++r) { const int d0_ = dbase - ((r & 3) + 8 * (r >> 2)), d1_ = d0_ - 32;
            float a = __builtin_amdgcn_exp2f(z0[r] - i0[r]), c = __builtin_amdgcn_exp2f(z1[r] - i1[r]);
            if (band) { a = d0_ > 0 ? a : 0.f; c = d1_ > 0 ? c : 0.f; }
            z0[r] = a; z1[r] = c; }
        carry = lowhalf(i0[0]);
        u32x4 pw0 = (u32x4){PKW(z0, 0), PKW(z0, 2), PKW(z0, 4), PKW(z0, 6)}, pw1 = (u32x4){PKW(z0, 8), PKW(z0, 10), PKW(z0, 12), PKW(z0, 14)};
        u32x4 pw2 = (u32x4){PKW(z1, 0), PKW(z1, 2), PKW(z1, 4), PKW(z1, 6)}, pw3 = (u32x4){PKW(z1, 8), PKW(z1, 10), PKW(z1, 12), PKW(z1, 14)};
        pv(o, vb0 + slot, __builtin_bit_cast(bf16x8, pw0), __builtin_bit_cast(bf16x8, pw1), __builtin_bit_cast(bf16x8, pw2), __builtin_bit_cast(bf16x8, pw3));
        if (__all(carry >= SB_EXIT)) done = true;
        }
        if (lane == 0) flg[(i & 1) * 8 + wid] = done ? 1u : 0u;
    }
    { long ro_ = rowbase + wq0; asm volatile("" : "+s"(ro_)); u32x4 zr[4]; load_gate(zr, Z + ro_ * PITCH + h * HD, lane); store_gated(o, nullptr, lds + LDS_OST + wid * 4096, zr, O + ro_ * OPITCH + h * HD, lane, r32, hi); }
    asm volatile("s_waitcnt vmcnt(0) lgkmcnt(0)\n\ts_barrier" ::: "memory");
#undef DMA_K
#undef DMA_V
}

__device__ __forceinline__ void sb_unit_w(int b, int h, int qb, const bf16* Q, const bf16* __restrict__ K, const bf16* __restrict__ V, const bf16* Z, bf16* O, LAS char* lds) {
    int tid_ = threadIdx.x; asm volatile("" : "+v"(tid_));
    const int tid = tid_, lane = tid & 63, r32 = lane & 31, hi = lane >> 5; const int wid = __builtin_amdgcn_readfirstlane(tid >> 6);
    const long rowbase = (long)b * SEQ; const int wq0 = qb * QB + wid * QBLK;
    const bf16* Qw = Q + (rowbase + wq0) * PITCH + h * HD;
    const bf16* Kh = K + rowbase * PITCH + h * HD; const bf16* Vh = V + rowbase * PITCH + h * HD;
    LAS char* wl = lds + wid * 16384;
    const unsigned lds0 = (unsigned)(uintptr_t)wl;
    const bf16* ksrc = Kh + (long)(lane & 31) * PITCH + (lane >> 5) * 8;
    const bf16* vsrc = Vh + (long)(lane >> 2) * PITCH + (lane & 3) * 8;
#define DMA_T(key0, bf) do { const unsigned d_ = (unsigned)__builtin_amdgcn_readfirstlane(lds0 + (bf) * 8192); const bf16* k_ = ksrc + (long)(key0) * PITCH; const bf16* v_ = vsrc + (long)(key0) * PITCH; \
        _Pragma("unroll") for (int i_ = 0; i_ < 4; ++i_) glds16(k_ + i_ * 16, d_ + i_ * 1024); \
        _Pragma("unroll") for (int i_ = 0; i_ < 4; ++i_) glds16(v_ + (long)((i_ & 1) * 16) * PITCH + (i_ >> 1) * 32, d_ + 4096 + i_ * 1024); } while (0)
    const int kt0 = wq0 >> 5;
    DMA_T(kt0 * 32, 0);
    bf16x8 qr[4];
#pragma unroll
    for (int d0 = 0; d0 < 4; ++d0) qr[d0] = *reinterpret_cast<const bf16x8*>(&Qw[(long)r32 * PITCH + d0 * 16 + hi * 8]);
    u32x4 zr[4]; load_gate(zr, Z + (rowbase + wq0) * PITCH + h * HD, lane);
    f16x8 tA[2];
#pragma unroll
    for (int s_ = 0; s_ < 2; ++s_)
#pragma unroll
        for (int jj = 0; jj < 8; ++jj) { const int key = 16 * s_ + 8 * (jj >> 2) + 4 * hi + (jj & 3); tA[s_][jj] = (key >= r32) ? (_Float16)1.0f : (_Float16)0.0f; }
    float carry = 0.f; f32x16 o[2]; o[0] = f32x16{}; o[1] = f32x16{};
    const int vbl = (int)lds0 + 4096 + ((lane >> 4) & 1) * 32 + (lane & 3) * 8 + (4 * hi + ((lane & 15) >> 2)) * 64;
#pragma unroll 1
    for (int i = 0;; ++i) { const int kt = kt0 - i, bf = i & 1;
        if (kt > 0) { DMA_T((kt - 1) * 32, bf ^ 1); asm volatile("s_waitcnt vmcnt(8)" ::: "memory"); }
        else asm volatile("s_waitcnt vmcnt(0)" ::: "memory");
        const lds_cptr kb = (lds_cptr)wl + bf * 8192 + hi * 512 + r32 * 16;
        f32x16 z = f32x16{};
#pragma unroll
        for (int d0 = 0; d0 < 4; ++d0) { const bf16x8 a = *(const LAS bf16x8*)(kb + d0 * 1024); z = __builtin_amdgcn_mfma_f32_32x32x16_bf16(a, qr[d0], z, 0, 0, 0); }
        const bool band = (i == 0);
        f32x16 l;
#pragma unroll
        for (int r = 0; r < 16; ++r) { float a = __builtin_fmaxf(z[r], 0.f) + __builtin_amdgcn_logf(1.0f + __builtin_amdgcn_exp2f(-__builtin_fabsf(z[r])));
            if (band) a = (((r & 3) + 8 * (r >> 2) + 4 * hi) < r32) ? a : 0.f;
            l[r] = a; }
        const u32x4 lf0 = (u32x4){cvtpk_h(l[0], l[1]), cvtpk_h(l[2], l[3]), cvtpk_h(l[4], l[5]), cvtpk_h(l[6], l[7])}, lf1 = (u32x4){cvtpk_h(l[8], l[9]), cvtpk_h(l[10], l[11]), cvtpk_h(l[12], l[13]), cvtpk_h(l[14], l[15])};
        f32x16 ct;
#pragma unroll
        for (int r = 0; r < 16; ++r) ct[r] = carry;
        f32x16 ii = __builtin_amdgcn_mfma_f32_32x32x16_f16(tA[0], __builtin_bit_cast(f16x8, lf0), ct, 0, 0, 0);
        ii = __builtin_amdgcn_mfma_f32_32x32x16_f16(tA[1], __builtin_bit_cast(f16x8, lf1), ii, 0, 0, 0);
#pragma unroll
        for (int r = 0; r < 16; ++r) { float a = __builtin_amdgcn_exp2f(z[r] - ii[r]); if (band) a = (((r & 3) + 8 * (r >> 2) + 4 * hi) < r32) ? a : 0.f; z[r] = a; }
        carry = lowhalf(ii[0]);
        const u32x4 pw0 = (u32x4){cvtpk(z[0], z[1]), cvtpk(z[2], z[3]), cvtpk(z[4], z[5]), cvtpk(z[6], z[7])}, pw1 = (u32x4){cvtpk(z[8], z[9]), cvtpk(z[10], z[11]), cvtpk(z[12], z[13]), cvtpk(z[14], z[15])};
        { const int vb = vbl + bf * 8192;
#pragma unroll
          for (int d0 = 0; d0 < 2; ++d0) { s16x4 lo[2], hh[2];
#pragma unroll
            for (int ks = 0; ks < 2; ++ks) {
                asm volatile("ds_read_b64_tr_b16 %0,%1 offset:%c2" : "=&v"(lo[ks]) : "v"(vb), "i"(d0 * 2048 + ks * 1024) : "memory");
                asm volatile("ds_read_b64_tr_b16 %0,%1 offset:%c2" : "=&v"(hh[ks]) : "v"(vb), "i"(d0 * 2048 + ks * 1024 + 512) : "memory"); }
            asm volatile("s_waitcnt lgkmcnt(0)" ::: "memory"); __builtin_amdgcn_sched_barrier(0);
            o[d0] = __builtin_amdgcn_mfma_f32_32x32x16_bf16(__builtin_bit_cast(bf16x8, pw0), (bf16x8){lo[0][0], lo[0][1], lo[0][2], lo[0][3], hh[0][0], hh[0][1], hh[0][2], hh[0][3]}, o[d0], 0, 0, 0);
            o[d0] = __builtin_amdgcn_mfma_f32_32x32x16_bf16(__builtin_bit_cast(bf16x8, pw1), (bf16x8){lo[1][0], lo[1][1], lo[1][2], lo[1][3], hh[1][0], hh[1][1], hh[1][2], hh[1][3]}, o[d0], 0, 0, 0); } }
        if (kt == 0 || __all(carry >= SB_EXIT)) break;
    }
    asm volatile("s_waitcnt vmcnt(0) lgkmcnt(0)" ::: "memory");
    { long ro_ = rowbase + wq0; asm volatile("" : "+s"(ro_)); store_gated(o, nullptr, wl, zr, O + ro_ * OPITCH + h * HD, lane, r32, hi); }
    asm volatile("s_waitcnt lgkmcnt(0)\n\ts_barrier" ::: "memory");
#undef DMA_T
}
#undef PKW
#undef MX3
#define WAIT_BAR(N) asm volatile("s_waitcnt vmcnt(" #N ") lgkmcnt(0)\n\ts_barrier":::"memory")
template<int THRL> __device__ __forceinline__ void moba_unit_t(int b,int h,int qb,const bf16*Q,const bf16*__restrict__ K,const bf16*__restrict__ V,const bf16*Z,bf16*O,const float*ksum,const LAS float*tab,LAS char*shm){
  int tid_=threadIdx.x; asm volatile("":"+v"(tid_));
  const int tid=tid_,lane=tid&63,r32=lane&31,hi=lane>>5; const int wid=__builtin_amdgcn_readfirstlane(tid>>6);
  const long rowbase=(long)b*SEQ; const int q0=qb*QB, wq0=q0+wid*QBLK;
  const bf16*Qw=Q+(rowbase+q0+wid*QBLK)*PITCH+h*HD;
  const bf16*Kh=K+rowbase*PITCH+h*HD,*Vh=V+rowbase*PITCH+h*HD;
  const unsigned lds0=(unsigned)(uintptr_t)shm;
  LAS float*wsf=(LAS float*)(shm+LDS_WS)+wid*64;
  const bf16*ksrc=Kh+(long)lane*PITCH+wid*8;
  const bf16*vsrc=Vh+(long)(16*(wid&3)+(lane>>2))*PITCH+(wid>>2)*32+(lane&3)*8;
  const unsigned kdst=lds0+LDS_K+wid*1024, vdst=lds0+LDS_V+wid*1024;
  #define DMA_K(t,slot) glds16(ksrc+(long)(t)*KVBLK*PITCH,(unsigned)__builtin_amdgcn_readfirstlane(kdst+(slot)))
  #define DMA_V(t,slot) glds16(vsrc+(long)(t)*KVBLK*PITCH,(unsigned)__builtin_amdgcn_readfirstlane(vdst+(slot)))
  const int vb0=(int)(lds0+LDS_V)+((lane>>4)&1)*32+(lane&3)*8+(4*hi+((lane&15)>>2))*64;
  const lds_cptr Kbase=(lds_cptr)shm+LDS_K; bf16x8 kf[8];
  const lds_cptr shm3=(lds_cptr)shm; const lds_cptr kp0=shm3+LDS_K+hi*1024+r32*16; const lds_cptr vp0=shm3+LDS_V+((lane>>4)&1)*32+(lane&3)*8+(4*hi+((lane&15)>>2))*64;
  const int NT=(q0+QB)/KVBLK;
  UTS(0);
  { const bf16*zs_=Z+(rowbase+wq0+(lane>>3))*PITCH+h*HD+(lane&7)*8; const unsigned zd_=(unsigned)__builtin_amdgcn_readfirstlane(lds0+LDS_ZST+wid*4096);
    _Pragma("unroll") for(int i=0;i<4;++i)glds16(zs_+(long)(8*i)*PITCH,zd_+i*1024); }
  DMA_K(0,0);DMA_V(0,0);DMA_K(1,SLOTB);
  bf16x8 qr[4];
  #pragma unroll
  for(int d0=0;d0<4;++d0)qr[d0]=*reinterpret_cast<const bf16x8*>(&Qw[(long)r32*PITCH+d0*16+hi*8]);
  unsigned selmask=(qb<=TOPK)?((1u<<qb)-1u):0u;
  if(qb>TOPK)selmask=moba_select(ksum,qr,qb,r32,hi);
  bool on=(qb==0)||(selmask&1u);
  float mhat=0.f,l_reg=0.f;f32x16 o[2];o[0]=f32x16{};o[1]=f32x16{};f32x16 negm;
  { const float nm_=on?0.f:-1e30f; _Pragma("unroll") for(int r=0;r<16;++r)negm[r]=nm_; } asm volatile("":"+v"(negm));
  #define NEARMASK(P0,P1,tt) do{ const int key0_=(tt)*KVBLK; \
    if(key0_>wq0+QBLK-1){ _Pragma("unroll") for(int r=0;r<16;++r){P0[r]=-1e30f;P1[r]=-1e30f;} }     \
    else if(wq0-(key0_+KVBLK-1)<128){ const int dbase_=wq0+r32-key0_-4*hi+1; \
      _Pragma("unroll") for(int r=0;r<16;++r){ const int d0_=dbase_-((r&3)+8*(r>>2)),d1_=d0_-32; const int i0_=d0_<0?0:(d0_>129?129:d0_),i1_=d1_<0?0:(d1_>129?129:d1_); \
        P0[r]+=tab[i0_]; P1[r]+=tab[i1_]; if((r&3)==3){ asm volatile("":"+v"(P0),"+v"(P1)); SBAR(); } } } }while(0)
  #define CMASK(P0,P1,t) NEARMASK(P0,P1,t)
  #define BLKUPD(tile) do{ if((((tile))&3)==0){ const int blk_=(tile)>>2; on=(blk_==qb)||((selmask>>blk_)&1u); const float nm_=on?-mhat:-1e30f; \
      _Pragma("unroll") for(int r=0;r<16;++r)negm[r]=nm_; asm volatile("":"+v"(negm)); } }while(0)
  bool resc=false;
  #define START(P0,P1) do{ const float rm=rowmax(P0,P1); resc=false; \
    { const float dl=(rm>-1e29f)?rm:0.f; mhat=fadd_s(mhat,dl); \
      _Pragma("unroll") for(int r=0;r<16;++r){P0[r]=fsub_s(P0[r],dl);P1[r]=fsub_s(P1[r],dl);} \
      { const float nm_=on?-mhat:-1e30f; _Pragma("unroll") for(int r=0;r<16;++r)negm[r]=nm_; } asm volatile("":"+v"(negm)); } \
    _Pragma("unroll") for(int r=0;r<16;++r)P0[r]=__builtin_amdgcn_exp2f(P0[r]); }while(0)
  #define RESC() do{ if(resc){ asm volatile("s_waitcnt lgkmcnt(0)":::"memory"); \
      _Pragma("unroll") for(int d_=0;d_<2;++d_) _Pragma("unroll") for(int r=0;r<16;++r)o[d_][r]*=wsf[crow(r,hi)]; } }while(0)
  f32x16 pA0,pA1,pB0,pB1;
  int sl_prev=0,sl_cur=0,sl_next=SLOTB;
  #define ROT() do{sl_prev=sl_cur;sl_cur=sl_next;sl_next=(sl_next==(NSLOT-1)*SLOTB)?0:sl_next+SLOTB;}while(0)
  DMA_K(2,2*SLOTB);
  WAIT_BAR(3);
  UTS(1);
  qkt(pA0,pA1,Kbase,qr,negm,r32,hi);asm volatile("s_nop 15\n\ts_nop 7":"+v"(pA0),"+v"(pA1));CMASK(pA0,pA1,0);
  START(pA0,pA1);
  _Pragma("unroll") for(int r=0;r<16;++r)pA1[r]=__builtin_amdgcn_exp2f(pA1[r]);
  WAIT_BAR(0);
  DMA_K(3,0);DMA_V(1,SLOTB);
  ROT();
  kload8(kf,kp0+sl_cur);
  WAIT_BAR(2);
  s16x4 vlo[8],vhi[8]; u32x4 pw0,pw1,pw2,pw3;
  #define PKW(P,B) cvtpk_s(P[B],P[B+1])
  #define PAF(k) __builtin_bit_cast(bf16x8,pw##k)
  #define VFR(i) (bf16x8){vlo[i][0],vlo[i][1],vlo[i][2],vlo[i][3],vhi[i][0],vhi[i][1],vhi[i][2],vhi[i][3]}
  #define PIN(x) asm volatile("":"+v"(x))
  #define MX3(a,b,c) __builtin_fmaxf(__builtin_fmaxf((a),(b)),(c))
  #define GAPA(MF,A0,A1,A2,A3,W0,W1,PW) do{ MF; sacc+=A0; sacc+=A1; sacc+=A2; sacc+=A3; PIN(sacc); W0; W1; PIN(PW); SBAR(); }while(0)
  #define EX(v) __builtin_amdgcn_exp2f(v)
  #define GAPB(MF,X,B) do{ MF; X[B]=EX(X[B]); X[B+1]=EX(X[B+1]); X[B+2]=EX(X[B+2]); X[B+3]=EX(X[B+3]); PIN(X); SBAR(); }while(0)
  #define VRD(i) do{ vlo[i]=vtr(vp_+(((i)>>2)*4096+((i)&3)*1024)); vhi[i]=vtr(vp_+(((i)>>2)*4096+((i)&3)*1024+512)); }while(0)
  #define KRD(G,j) do{ if(G){ kload2(kf,kp0+sl_next,j); SBAR(); } }while(0)
  #define STEP(C0,C1,P0,P1,t,GK,GV,GL) do{ SBAR(); \
    const lds_cptr vp_=vp0+sl_prev; \
    VRD(0); SBAR(); float sacc=(P0[0]+P0[1]); \
    GAPA(C0=__builtin_amdgcn_mfma_f32_32x32x16_bf16(kf[0],qr[0],negm,0,0,0), P0[2],P0[3],P0[4],P0[5],     pw0[0]=PKW(P0,0), pw0[1]=PKW(P0,2), pw0); \
    VRD(4); SBAR(); GAPA(C1=__builtin_amdgcn_mfma_f32_32x32x16_bf16(kf[1],qr[0],negm,0,0,0), P0[6],P0[7],P0[8],P0[9],     pw0[2]=PKW(P0,4), pw0[3]=PKW(P0,6), pw0); \
    VRD(1); SBAR(); GAPA(C0=__builtin_amdgcn_mfma_f32_32x32x16_bf16(kf[2],qr[1],C0,0,0,0),   P0[10],P0[11],P0[12],P0[13], pw1[0]=PKW(P0,8), pw1[1]=PKW(P0,10), pw1); \
    VRD(5); SBAR(); GAPA(C1=__builtin_amdgcn_mfma_f32_32x32x16_bf16(kf[3],qr[1],C1,0,0,0),   P0[14],P0[15],P1[0],P1[1],   pw1[2]=PKW(P0,12),pw1[3]=PKW(P0,14), pw1); \
    VRD(2); SBAR(); GAPA(C0=__builtin_amdgcn_mfma_f32_32x32x16_bf16(kf[4],qr[2],C0,0,0,0),   P1[2],P1[3],P1[4],P1[5],     pw2[0]=PKW(P1,0), pw2[1]=PKW(P1,2), pw2); \
    VRD(6); SBAR(); GAPA(C1=__builtin_amdgcn_mfma_f32_32x32x16_bf16(kf[5],qr[2],C1,0,0,0),   P1[6],P1[7],P1[8],P1[9],     pw2[2]=PKW(P1,4), pw2[3]=PKW(P1,6), pw2); \
    VRD(3); SBAR(); GAPA(C0=__builtin_amdgcn_mfma_f32_32x32x16_bf16(kf[6],qr[3],C0,0,0,0),   P1[10],P1[11],P1[12],P1[13], pw3[0]=PKW(P1,8), pw3[1]=PKW(P1,10), pw3); \
    VRD(7); SBAR(); GAPA(C1=__builtin_amdgcn_mfma_f32_32x32x16_bf16(kf[7],qr[3],C1,0,0,0),   P1[14],P1[15],0.f,0.f,       pw3[2]=PKW(P1,12),pw3[3]=PKW(P1,14), pw3); \
    l_reg+=sacc; \
    if(GK){DMA_K((t)+3,sl_cur);} if(GV){DMA_V((t)+1,sl_next);} \
    CMASK(C0,C1,t); \
    { float a=MX3(C0[0],C0[1],C1[0]),b=MX3(C0[2],C0[3],C1[1]); a=MX3(a,C1[2],C1[3]); \
      _Pragma("unroll") for(int r=4;r<16;r+=4){a=MX3(a,C0[r],C0[r+1]);b=MX3(b,C0[r+2],C0[r+3]);a=MX3(a,C1[r],C1[r+1]);b=MX3(b,C1[r+2],C1[r+3]);} \
      float rm=__builtin_fmaxf(a,b); { auto rr=__builtin_amdgcn_permlane32_swap(__float_as_uint(rm),__float_as_uint(rm),false,false); rm=__builtin_fmaxf(__uint_as_float(rr[0]),__uint_as_float(rr[1])); } \
      resc=false; \
      if(__builtin_expect(__any(rm>(float)THRL),0)){ const float dl=__builtin_fmaxf(rm,0.f); mhat+=dl; \
        _Pragma("unroll") for(int r=0;r<16;++r){C0[r]-=dl;C1[r]-=dl;} \
        { const float nm_=on?-mhat:-1e30f; _Pragma("unroll") for(int r=0;r<16;++r)negm[r]=nm_; } asm volatile("":"+v"(negm)); \
        const float f=__builtin_amdgcn_exp2f(-dl); l_reg*=f; if(hi==0)wsf[r32]=f; resc=true; } } \
    SBAR(); \
    GAPB(o[0]=__builtin_amdgcn_mfma_f32_32x32x16_bf16(PAF(0),VFR(0),o[0],0,0,0), C0,0); \
    GAPB(o[1]=__builtin_amdgcn_mfma_f32_32x32x16_bf16(PAF(0),VFR(4),o[1],0,0,0), C0,4); \
    KRD(GL,0); GAPB(o[0]=__builtin_amdgcn_mfma_f32_32x32x16_bf16(PAF(1),VFR(1),o[0],0,0,0), C0,8); \
    KRD(GL,1); GAPB(o[1]=__builtin_amdgcn_mfma_f32_32x32x16_bf16(PAF(1),VFR(5),o[1],0,0,0), C0,12); \
    KRD(GL,2); GAPB(o[0]=__builtin_amdgcn_mfma_f32_32x32x16_bf16(PAF(2),VFR(2),o[0],0,0,0), C1,0); \
    KRD(GL,3); GAPB(o[1]=__builtin_amdgcn_mfma_f32_32x32x16_bf16(PAF(2),VFR(6),o[1],0,0,0), C1,4); \
    GAPB(o[0]=__builtin_amdgcn_mfma_f32_32x32x16_bf16(PAF(3),VFR(3),o[0],0,0,0), C1,8); \
    GAPB(o[1]=__builtin_amdgcn_mfma_f32_32x32x16_bf16(PAF(3),VFR(7),o[1],0,0,0), C1,12); \
    }while(0)
  int t=1;
  UTS(2);
  #undef CMASK
  #define CMASK(P0,P1,t) do{}while(0)
  for(;t+9<NT;t+=2){
    BLKUPD(t);   STEP(pB0,pB1,pA0,pA1,t,true,true,true);     WAIT_BAR(2); RESC(); ROT();
    BLKUPD(t+1); STEP(pA0,pA1,pB0,pB1,t+1,true,true,true);   WAIT_BAR(2); RESC(); ROT();
  }
  #undef CMASK
  #define CMASK(P0,P1,t) NEARMASK(P0,P1,t)
  #define ENDW(tt) do{ if((tt)+3<NT){WAIT_BAR(2);} else if((tt)+2<NT){WAIT_BAR(1);} else {WAIT_BAR(0);} }while(0)
  for(;t+1<NT;t+=2){
    BLKUPD(t);   STEP(pB0,pB1,pA0,pA1,t,(t+3<NT),(t+1<NT),(t+1<NT));       ENDW(t);   RESC(); ROT();
    BLKUPD(t+1); STEP(pA0,pA1,pB0,pB1,t+1,(t+4<NT),(t+2<NT),(t+2<NT));     ENDW(t+1); RESC(); ROT();
  }
  BLKUPD(NT-1); STEP(pB0,pB1,pA0,pA1,NT-1,false,false,false); RESC();
  { float sacc=pB0[0]+pB0[1]; _Pragma("unroll") for(int r=2;r<16;++r)sacc+=pB0[r]; _Pragma("unroll") for(int r=0;r<16;++r)sacc+=pB1[r]; l_reg+=sacc;
    pw0=(u32x4){PKW(pB0,0),PKW(pB0,2),PKW(pB0,4),PKW(pB0,6)};pw1=(u32x4){PKW(pB0,8),PKW(pB0,10),PKW(pB0,12),PKW(pB0,14)};pw2=(u32x4){PKW(pB1,0),PKW(pB1,2),PKW(pB1,4),PKW(pB1,6)};pw3=(u32x4){PKW(pB1,8),PKW(pB1,10),PKW(pB1,12),PKW(pB1,14)};
    SBAR(); pv(o,vb0+sl_cur,PAF(0),PAF(1),PAF(2),PAF(3)); }
  #undef PKW
  #undef PAF
  #undef VFR
  #undef PIN
  #undef MX3
  #undef GAPA
  #undef GAPB
  #undef EX
  #undef VRD
  #undef KRD
  #undef STEP
  #undef ENDW
  UTS(3);
  {auto rr=__builtin_amdgcn_permlane32_swap(__float_as_uint(l_reg),__float_as_uint(l_reg),false,false);l_reg=__uint_as_float(rr[0])+__uint_as_float(rr[1]);}
  if(hi==0)wsf[32+r32]=l_reg;asm volatile("s_waitcnt lgkmcnt(0)":::"memory");
  float rli[16];
  #pragma unroll
  for(int r=0;r<16;++r)rli[r]=__builtin_amdgcn_rcpf(wsf[32+crow(r,hi)]);
  { long ro_=rowbase+wq0; asm volatile("":"+s"(ro_)); u32x4 zr[4]; _Pragma("unroll") for(int i=0;i<4;++i)zr[i]=*(const LAS u32x4*)(shm+LDS_ZST+wid*4096+i*1024+lane*16); store_gated(o,rli,shm+LDS_OST+wid*4096,zr,O+ro_*OPITCH+h*HD,lane,r32,hi); }
  asm volatile("s_waitcnt lgkmcnt(0)\n\ts_barrier":::"memory");
  UTS(4);
  #undef DMA_K
  #undef DMA_V
  #undef CMASK
  #undef NEARMASK
  #undef BLKUPD
  #undef START
  #undef RESC
  #undef ROT
}
#undef WAIT_BAR
#undef SBAR
#undef WAIT_BAR0
}

typedef unsigned short bf16;
typedef unsigned v4u __attribute__((ext_vector_type(4)));
typedef float f32x4 __attribute__((ext_vector_type(4)));
typedef short bf16x8 __attribute__((ext_vector_type(8)));
typedef GAS unsigned gu32;
typedef GAS unsigned long long gu64;
#define RLX_AGENT __ATOMIC_RELAXED, __HIP_MEMORY_SCOPE_AGENT
#define LDS_WAIT() asm volatile("s_waitcnt lgkmcnt(0)" ::: "memory")
#define VM_WAIT() asm volatile("s_waitcnt vmcnt(0)" ::: "memory")
__device__ __forceinline__ unsigned long long rt() { return __builtin_amdgcn_s_memrealtime(); }
__device__ __forceinline__ unsigned f2bf(float f) { unsigned u = __builtin_bit_cast(unsigned, f); return (u + 0x7fffu + ((u >> 16) & 1u)) >> 16; }
__device__ __forceinline__ unsigned pk2(float lo, float hi) { return f2bf(lo) | (f2bf(hi) << 16); }

#define XB_TMO      128
#define XB_XCNT(j)  (256  + 64 * (j))
#define XB_XSUB(j)  (1280 + 64 * (j))
#define XB_XGEN(j)  (2304 + 64 * (j))
#define XB_TOP      3328
#define XB_TOPGEN   3392
#define XCD_BAR_WORDS 3456
#define XB_SPIN_CAP (1u << 18)

__device__ __forceinline__ unsigned xb_ld(unsigned* p)              { return __hip_atomic_load(p, __ATOMIC_RELAXED, __HIP_MEMORY_SCOPE_AGENT); }
__device__ __forceinline__ unsigned xb_add(unsigned* p, unsigned v) { return __hip_atomic_fetch_add(p, v, __ATOMIC_RELAXED, __HIP_MEMORY_SCOPE_AGENT); }
__device__ __forceinline__ unsigned xb_xcc_id() { return (unsigned)__builtin_amdgcn_s_getreg((3 << 11) | 20) & 0xFu; }
#define XB_SPIN(cond, bar) do { unsigned _sp = 0; while (cond) { __builtin_amdgcn_s_sleep(1); \
    if ((++_sp & 255u) == 0u) { if (xb_ld(&(bar)[XB_TMO])) break; if (_sp > XB_SPIN_CAP) { atomicAdd(&(bar)[XB_TMO], 1u); break; } } } } while (0)

struct XcdBarrier {
    unsigned* bar; unsigned x;
    volatile LAS unsigned* st;
};

__device__ __forceinline__ XcdBarrier xcd_barrier_post(unsigned* bar, volatile LAS unsigned* st) {
    XcdBarrier b; b.bar = bar; b.x = xb_xcc_id(); b.st = st;
    if (threadIdx.x == 0) (void)xb_add(&bar[XB_XCNT(b.x)], 1u);
    return b;
}
__device__ __forceinline__ void xcd_barrier_complete(unsigned* bar, unsigned x, unsigned& nloc, unsigned& nx) {
    const unsigned G = gridDim.x * gridDim.y * gridDim.z;
    unsigned sum, cnt, mine, sp = 0u;
    for (;;) {
        sum = 0u; cnt = 0u; mine = 0u;
#pragma unroll
        for (unsigned j = 0; j < 16; ++j) { const unsigned c = xb_ld(&bar[XB_XCNT(j)]); sum += c; cnt += (c > 0u) ? 1u : 0u; mine = (j == x) ? c : mine; }
        if (sum == G) break;
        __builtin_amdgcn_s_sleep(1);
        if ((++sp & 255u) == 0u) { if (xb_ld(&bar[XB_TMO])) break; if (sp > XB_SPIN_CAP) { atomicAdd(&bar[XB_TMO], 1u); break; } }
    }
    nloc = mine > 0u ? mine : 1u; nx = cnt > 0u ? cnt : 1u;
}

__device__ __forceinline__ void xcd_barrier(const XcdBarrier& b) {
    asm volatile("s_waitcnt vmcnt(0)" ::: "memory");
    __syncthreads();
    if (threadIdx.x == 0) {
        unsigned* bar = b.bar;
        __builtin_amdgcn_s_waitcnt(0);
        unsigned nloc = b.st[0], nx = b.st[1];
        if (nloc == 0u) { xcd_barrier_complete(bar, b.x, nloc, nx); b.st[0] = nloc; b.st[1] = nx; }
        const unsigned old = xb_add(&bar[XB_XSUB(b.x)], 1u);
        const unsigned gen = old / nloc;
        if (old + 1u == (gen + 1u) * nloc) {
            __builtin_amdgcn_fence(__ATOMIC_RELEASE, "agent");
            asm volatile("s_waitcnt vmcnt(0)" ::: "memory");
            const unsigned og = xb_add(&bar[XB_TOP], 1u);
            const unsigned tg = og / nx;
            if (og + 1u == (tg + 1u) * nx) xb_add(&bar[XB_TOPGEN], 1u);
            else XB_SPIN(xb_ld(&bar[XB_TOPGEN]) == tg, bar);
            __builtin_amdgcn_fence(__ATOMIC_ACQUIRE, "agent");
            xb_add(&bar[XB_XGEN(b.x)], 1u);
            asm volatile("s_waitcnt vmcnt(0)" ::: "memory");
        } else {
            XB_SPIN(xb_ld(&bar[XB_XGEN(b.x)]) == gen, bar);
            __builtin_amdgcn_fence(__ATOMIC_ACQUIRE, "agent");
            asm volatile("s_waitcnt vmcnt(0)" ::: "memory");
        }
    }
    __syncthreads();
}


#ifndef P0_NTL
#define P0_NTL 1
#endif
#ifndef W_NTL
#define W_NTL 0
#endif
constexpr int NWAVES = 8;
constexpr int RING_OFF = 0, RING_BYTES = 131072;
constexpr int LDSCTL_OFF = RING_BYTES, MISC_OFF = LDSCTL_OFF + 320;
constexpr int LDS_BYTES = 147456;
static_assert(attn::LDS_BYTES <= RING_BYTES && MISC_OFF + 128 <= LDS_BYTES, "LDS map");

struct Frame {
    LAS unsigned char* lds; volatile LAS unsigned* MISC; gu32* ctl;
    int tid, lane, wave, vcu, G;
};
__device__ __forceinline__ float wave_sum(float v) {
#pragma unroll
    for (int o = 1; o < 64; o <<= 1) v += __shfl_xor(v, o);
    return v;
}
template <int ROWMAP>
__device__ __forceinline__ void p0_transpose_item(const float* Wsrc, int K, int N, bf16* WT, int ldt, int koff, LAS float* scr, int item, int lane) {
    const int nblk = N / 32, kb = item / nblk, nb = item % nblk, k0 = 64 * kb, n0 = 32 * nb;
    float t[32];
#pragma unroll
    for (int i = 0; i < 32; ++i) t[i] = W_NTL ? __builtin_nontemporal_load(Wsrc + (size_t)(k0 + 2 * i + (lane >> 5)) * N + n0 + (lane & 31)) : Wsrc[(size_t)(k0 + 2 * i + (lane >> 5)) * N + n0 + (lane & 31)];
#pragma unroll
    for (int i = 0; i < 32; ++i) scr[(2 * i + (lane >> 5)) * 33 + (lane & 31)] = t[i];
    LDS_WAIT(); asm volatile("" ::: "memory");
    const int c = lane & 7; const int drow0 = (ROWMAP == 1) ? win_row_of_col(n0) : phys_of_actual(n0);
#pragma unroll
    for (int j = 0; j < 4; ++j) { const int n = (lane >> 3) + 8 * j; const LAS float* s = scr + (8 * c) * 33 + n;
        v4u o; o.x = pk2(s[0 * 33], s[1 * 33]); o.y = pk2(s[2 * 33], s[3 * 33]); o.z = pk2(s[4 * 33], s[5 * 33]); o.w = pk2(s[6 * 33], s[7 * 33]);
        *(GAS v4u*)(WT + (size_t)(drow0 + n) * ldt + koff + k0 + 8 * c) = o; }
    LDS_WAIT(); asm volatile("" ::: "memory");
}
template <int NR>
__device__ __forceinline__ void rms_rows_to_bf16(const float* xrow, const float* nw, bf16* orow, int lane) {
    f32x4 v[NR][4];
#pragma unroll
    for (int r = 0; r < NR; ++r) { const GAS f32x4* xr = (const GAS f32x4*)(xrow + (size_t)r * DM) + lane;
#pragma unroll
        for (int j = 0; j < 4; ++j) {
#if P0_NTL
            v[r][j] = __builtin_nontemporal_load((const f32x4*)(xrow + (size_t)r * DM) + lane + 64 * j);
#else
            v[r][j] = xr[64 * j];
#endif
        } }
    const GAS f32x4* wr_ = (const GAS f32x4*)nw + lane; f32x4 w[4];
#pragma unroll
    for (int j = 0; j < 4; ++j) w[j] = wr_[64 * j];
#pragma unroll
    for (int r = 0; r < NR; ++r) { float s = 0.f;
#pragma unroll
        for (int j = 0; j < 4; ++j) s += (v[r][j].x * v[r][j].x + v[r][j].y * v[r][j].y) + (v[r][j].z * v[r][j].z + v[r][j].w * v[r][j].w);
        const float rstd = 1.f / sqrtf(wave_sum(s) * (1.f / DM) + EPS);
        GAS unsigned long long* o8 = (GAS unsigned long long*)(orow + (size_t)r * DM) + lane;
#pragma unroll
        for (int j = 0; j < 4; ++j) { const unsigned long long pk_ = (unsigned long long)pk2(v[r][j].x * rstd * w[j].x, v[r][j].y * rstd * w[j].y) | ((unsigned long long)pk2(v[r][j].z * rstd * w[j].z, v[r][j].w * rstd * w[j].w) << 32);
#ifdef P0_NT
            __builtin_nontemporal_store(pk_, (unsigned long long*)(orow + (size_t)r * DM) + lane + 64 * j);
#else
            o8[64 * j] = pk_;
#endif
        } }
}

struct Args { const float* in[10]; float* out; unsigned char* ws; int ph_lo, ph_hi; };

__global__ void __launch_bounds__(NWAVES * 64, 2) hybrid_fwd(Args args) {
    extern __shared__ __attribute__((aligned(16))) unsigned char lds[];
    Frame F;
    F.lds = (LAS unsigned char*)lds; F.MISC = (volatile LAS unsigned*)(F.lds + MISC_OFF);
    F.tid = threadIdx.x; F.lane = F.tid & 63; F.wave = __builtin_amdgcn_readfirstlane(F.tid >> 6);
    F.G = gridDim.x; { const int bx = blockIdx.x; F.vcu = (F.G % 8 == 0) ? (bx % 8) * (F.G / 8) + bx / 8 : bx; }
    unsigned char* ws = args.ws; F.ctl = (gu32*)(ws + WS_CTL);
    for (int u = F.tid; u < (LDS_BYTES - LDSCTL_OFF) / 4; u += NWAVES * 64) ((LAS unsigned*)(F.lds + LDSCTL_OFF))[u] = 0u;
    __syncthreads();
    const int lo = args.ph_lo, hi = args.ph_hi;
    const bool multi = (hi - lo) > 1;
    XcdBarrier bar; bar.bar = (unsigned*)(F.ctl + CW_BAR); bar.x = 0; bar.st = nullptr;
    if (multi) bar = xcd_barrier_post((unsigned*)(F.ctl + CW_BAR), F.MISC + 8);
#define IN(k) (lo <= (k) && (k) < hi)
    unsigned long long* stamps = (unsigned long long*)(ws + 128 * 1024);
#ifndef PT_K
#define PT_K (-1)
#endif
#ifndef PT_KIND
#define PT_KIND 0
#endif
#ifndef PT_AMP
#define PT_AMP 16
#endif
#define STAMP(k) do { if (PT_K >= 0) { if (F.tid == 0) __hip_atomic_store(stamps + (k) * 256 + blockIdx.x, rt(), __ATOMIC_RELAXED, __HIP_MEMORY_SCOPE_AGENT); } } while (0)
#define PTDELAY(kb) do { if (PT_K == (kb) && blockIdx.x == 0 && F.wave == 0) { \
        unsigned long long mn_ = ~0ull, mx_ = 0ull; \
        for (int j_ = F.lane; j_ < F.G; j_ += 64) { const unsigned long long v_ = __hip_atomic_load(stamps + ((PT_KIND == 3) ? 0 : (2 * (kb) + 1)) * 256 + j_, __ATOMIC_RELAXED, __HIP_MEMORY_SCOPE_AGENT); mn_ = v_ < mn_ ? v_ : mn_; mx_ = v_ > mx_ ? v_ : mx_; } \
        for (int o_ = 1; o_ < 64; o_ <<= 1) { const unsigned long long a_ = __shfl_xor(mn_, o_), b_ = __shfl_xor(mx_, o_); mn_ = a_ < mn_ ? a_ : mn_; mx_ = b_ > mx_ ? b_ : mx_; } \
        const unsigned long long ex_ = __hip_atomic_load(stamps + (2 * (kb) + 2) * 256, __ATOMIC_RELAXED, __HIP_MEMORY_SCOPE_AGENT), pv_ = __hip_atomic_load(stamps + (2 * (kb)) * 256, __ATOMIC_RELAXED, __HIP_MEMORY_SCOPE_AGENT); \
        const unsigned long long X_ = (PT_KIND == 0 || PT_KIND == 3) ? (mx_ - mn_) : (PT_KIND == 1) ? (ex_ - mx_) : (PT_KIND == 4) ? (mx_ - __hip_atomic_load(stamps, __ATOMIC_RELAXED, __HIP_MEMORY_SCOPE_AGENT)) : (mx_ - pv_);         \
        const unsigned long long t0_ = rt(); while (rt() - t0_ < (unsigned long long)PT_AMP * X_) __builtin_amdgcn_s_sleep(8); } \
      if (PT_K == (kb)) __syncthreads(); } while (0)
    STAMP(0);
#ifndef DUP_MASK
#define DUP_MASK 0
#endif
#define NREP(k) (((DUP_MASK >> (k)) & 1) ? 2 : 1)
#define BOTH(k) (IN(k) && IN((k) + 1))
    const float* x = args.in[0];
    bf16* Wt_in = (bf16*)(ws + WS_WIN); bf16* Wt_up = (bf16*)(ws + WS_WUP); bf16* Wt_out = (bf16*)(ws + WS_WOUT);
    bf16* Hb = (bf16*)(ws + WS_H);

#ifndef NPASS
#define NPASS 1
#endif
#ifndef WARM_NEXT
#define WARM_NEXT 0
#endif
#ifndef BARX
#define BARX 1
#endif
#if BARX == 1
#define GBAR() xcd_barrier(bar)
#else
#define GBAR() do { for (int bx_ = 0; bx_ < BARX; ++bx_) xcd_barrier(bar); } while (0)
#endif
#ifndef NO_P0
    if (IN(0)) {
        LAS float* scr = (LAS float*)(F.lds + RING_OFF + F.wave * 16384);
        const int gw = F.vcu * NWAVES + F.wave, NGW = F.G * NWAVES;
        constexpr int I_IN = (DM / 64) * (INW / 32), I_UP = (W / 64) * (DM / 32), I_OUT = (DM / 64) * (DM / 32);
        constexpr int NITEMS = I_IN + 2 * I_UP + I_OUT;
        for (int rep = 0; rep < NREP(0); ++rep) {
        for (int it = gw; it < NITEMS; it += NGW) { int r = it;
            if (r < I_IN) { p0_transpose_item<1>(args.in[2], DM, INW, Wt_in, DM, 0, scr, r, F.lane); continue; } r -= I_IN;
            if (r < I_UP) { p0_transpose_item<0>(args.in[7], W, DM, Wt_up, DM, 0, scr, r, F.lane); continue; } r -= I_UP;
            if (r < I_UP) { p0_transpose_item<0>(args.in[8], W, DM, Wt_up, DM, W, scr, r, F.lane); continue; } r -= I_UP;
            p0_transpose_item<0>(args.in[9], DM, DM, Wt_out, DM, 0, scr, r, F.lane); }
        for (int m = 4 * gw; m < M; m += 4 * NGW) rms_rows_to_bf16<4>(x + (size_t)m * DM, args.in[1], Hb + (size_t)m * DM, F.lane);
        }
        STAMP(1); if (BOTH(0)) GBAR(); STAMP(2); PTDELAY(0);
    }
#endif
#ifndef NO_P1
    if (IN(1)) {
        pg8::Gemm g{Hb, Wt_in, M, INW, DM, DM, DM}; pg8::StaticOrder S; S.init(M, INW, F.G, (int)blockIdx.x);
        pg8::EpiProj E{ws, args.in[3], args.in[4], args.in[5], 0};
#ifdef STAGGER_TICKS
        { const unsigned long long t0_ = rt(); const unsigned long long dly_ = (unsigned long long)((blockIdx.x >> 3) & 3) * STAGGER_TICKS; while (rt() - t0_ < dly_) __builtin_amdgcn_s_sleep(4); }
#endif
        for (int rep = 0; rep < NREP(1); ++rep) {
#ifdef DUP_NOSTORE
        if (rep == 1) E.nostore = 1;
#endif
        pg8::gemm_phase<pg8::EpiProj, pg8::StaticOrder, true, true>(F.lds + RING_OFF, g, S, E); }
        STAMP(3); if (BOTH(1)) GBAR(); STAMP(4); PTDELAY(1);
    }
#endif
#ifndef NO_P2
    if (IN(2)) {
        const bf16* QA = (const bf16*)(ws + WS_P); const bf16* KA = QA + (size_t)M * W; const bf16* VA = KA + (size_t)M * W; const bf16* ZA = VA + (size_t)M * W;
        const bf16* QB_ = ZA + (size_t)M * W; const bf16* KB_ = QB_ + (size_t)M * W; const bf16* VB_ = KB_ + (size_t)M * W; const bf16* ZB_ = VB_ + (size_t)M * W;
        LAS float* tabs = (LAS float*)(F.lds + LDSCTL_OFF + 10240);
        attn::moba_tables(tabs, args.in[6], F.tid); __syncthreads();
        const unsigned myx = xb_xcc_id() & 7u;
        const unsigned dummy = (unsigned)__builtin_amdgcn_readfirstlane((unsigned)(uintptr_t)(F.lds + LDSCTL_OFF + 2048) + (unsigned)F.wave * 1024u);
#pragma unroll 1
        for (int pass = 0; pass < NREP(2); ++pass) {
#define POP_DESC(dst) do { dst = 0xffffffffu; while (qi < 8) { const unsigned q_ = (myx + (unsigned)qi) & 7u; \
            const unsigned u_ = __hip_atomic_fetch_add((unsigned*)(F.ctl + CW_QUEUE + 64 * q_ + 1024 * pass), 1u, __ATOMIC_RELAXED, __HIP_MEMORY_SCOPE_AGENT); if (u_ < 256u) { dst = (q_ << 8) | u_; break; } ++qi; } } while (0)
        if (F.tid == 0) { int qi = 0; unsigned d0_, d1_; POP_DESC(d0_); POP_DESC(d1_); F.MISC[20] = d0_; F.MISC[21] = d1_; F.MISC[22] = (unsigned)qi; }
        __syncthreads(); unsigned cur = F.MISC[20], nxt = F.MISC[21]; __syncthreads();
#pragma unroll 1
        while (cur != 0xffffffffu) {
#define DECODE(d, is_sb, b, h, qb) const int cls_##b = (int)(((d) & 255u) >> 4), bh_##b = 16 * (int)((d) >> 8) + (int)((d) & 15u); const int b = bh_##b >> 3, h = bh_##b & 7; \
            const bool is_sb = (cls_##b >= 6 && cls_##b <= 12) || cls_##b == 14; const int qb = (cls_##b < 6) ? 7 - cls_##b : (cls_##b <= 12) ? 13 - cls_##b : (cls_##b == 13) ? 1 : 0
            if (WARM_NEXT && nxt != 0xffffffffu) { DECODE(nxt, nsb, nb, nh, nqb); const long r0 = (long)nb * SEQ, rq = r0 + nqb * 256;
                if (!nsb) { attn::warm_rows(KA + nh * 64, r0, 3, dummy, F.wave, F.lane); attn::warm_rows(VA + nh * 64, r0, 1, dummy, F.wave, F.lane); attn::warm_rows(QA + nh * 64, rq, 4, dummy, F.wave, F.lane); attn::warm_rows(ZA + nh * 64, rq, 4, dummy, F.wave, F.lane); }
                else { attn::warm_rows(KB_ + nh * 64, rq, 4, dummy, F.wave, F.lane); attn::warm_rows(VB_ + nh * 64, rq, 4, dummy, F.wave, F.lane); attn::warm_rows(QB_ + nh * 64, rq, 4, dummy, F.wave, F.lane); attn::warm_rows(ZB_ + nh * 64, rq, 4, dummy, F.wave, F.lane); } }
            { DECODE(cur, csb, cb, ch, cqb);
                if (!csb) attn::moba_unit_t<8>(cb, ch, cqb, QA, KA, VA, ZA, Hb, (const float*)(ws + WS_KSUM) + (size_t)(cb * 8 + ch) * NBLK * 64, tabs + ch * 132, (LAS char*)(F.lds + RING_OFF));
                else attn::sb_unit_w(cb, ch, cqb, QB_, KB_, VB_, ZB_, Hb + W, (LAS char*)(F.lds + RING_OFF)); }
            if (F.tid == 0) { unsigned nn = 0xffffffffu; if (nxt != 0xffffffffu) { int qi = (int)F.MISC[22]; POP_DESC(nn); F.MISC[22] = (unsigned)qi; } F.MISC[20] = nn; }
            __syncthreads();
            cur = nxt; nxt = F.MISC[20];
        }
#undef POP_DESC
#undef DECODE
        }
#ifdef UT_PROBE
        if (blockIdx.x == 0 && F.tid == 0) { volatile LAS unsigned long long* u_ = (volatile LAS unsigned long long*)(F.lds + 132096); const unsigned long long X_ = u_[UT_B] - u_[UT_A];
            const unsigned long long t0_ = rt(); while (rt() - t0_ < (unsigned long long)UT_AMP * X_) __builtin_amdgcn_s_sleep(8); }
        __syncthreads();
#endif
        STAMP(5); if (BOTH(2)) GBAR(); STAMP(6); PTDELAY(2);
    }
#endif
#ifndef NO_P3
    if (IN(3)) {
        pg8::Gemm g{Hb, Wt_up, M, DM, DM, DM, DM}; pg8::StaticOrder S; S.init(M, DM, F.G, (int)blockIdx.x, NREP(3));
        pg8::EpiY E{(const bf16*)(ws + WS_GR), (const bf16*)(ws + WS_GB), (bf16*)(ws + WS_Y), (LAS unsigned*)(F.lds + LDSCTL_OFF + 2048 + F.wave * 1024)};
        pg8::gemm_phase<pg8::EpiY, pg8::StaticOrder, true, true>(F.lds + RING_OFF, g, S, E);
        STAMP(7); if (BOTH(3)) GBAR(); STAMP(8); PTDELAY(3);
    }
#endif
#ifndef NO_P4
    if (IN(4)) {
        pg8::Gemm g{(const bf16*)(ws + WS_Y), Wt_out, M, DM, DM, DM, DM}; pg8::StaticOrder S; S.init(M, DM, F.G, (int)blockIdx.x);
        pg8::EpiOut E{x, args.out};
        for (int rep = 0; rep < NREP(4); ++rep)
        pg8::gemm_phase<pg8::EpiOut, pg8::StaticOrder, true, true>(F.lds + RING_OFF, g, S, E);
    }
#endif
    if (PT_K == 4) { STAMP(9); xcd_barrier(bar); STAMP(10); PTDELAY(4); }
#undef IN
#undef BOTH
}

__global__ void noop_kernel(int* p) { if (threadIdx.x == 1000) p[0] = 1; }
#ifndef MK_CUTS
#define MK_CUTS 1
#endif
extern "C" void kernel_launch(void* const* d_in, const int* in_sizes, int n_in, void* d_out, int out_size, void* d_ws, size_t ws_size, hipStream_t stream) {
    static int grid = 0;
    if (grid == 0) {
        if (n_in != 10 || in_sizes[0] != M * DM || out_size != M * DM || ws_size < WS_END) { fprintf(stderr, "kernel_launch: unexpected shapes / workspace (%d inputs, x %d, out %d, ws %zu)\n", n_in, n_in > 0 ? in_sizes[0] : -1, out_size, ws_size); grid = -1; return; }
        int dev = 0, cus = 0, per_cu = 0;
        if (hipGetDevice(&dev) != hipSuccess || hipDeviceGetAttribute(&cus, hipDeviceAttributeMultiprocessorCount, dev) != hipSuccess) { grid = -1; return; }
        if (hipFuncSetAttribute((const void*)hybrid_fwd, hipFuncAttributeMaxDynamicSharedMemorySize, LDS_BYTES) != hipSuccess) { fprintf(stderr, "kernel_launch: hipFuncSetAttribute failed\n"); grid = -1; return; }
        if (hipOccupancyMaxActiveBlocksPerMultiprocessor(&per_cu, (const void*)hybrid_fwd, NWAVES * 64, LDS_BYTES) != hipSuccess || per_cu < 1) fprintf(stderr, "kernel_launch: note: occupancy query reports %d\n", per_cu);
        (void)hipGetLastError();
        grid = cus;
    }
    if (grid < 0) return;
#ifdef XMEMSET
    for (int i = 0; i < XMEMSET; ++i) (void)hipMemsetAsync((char*)d_ws + WS_CTL, 0, CTL_ZERO_BYTES, stream);
#endif
#ifdef XKERNEL
    for (int i = 0; i < XKERNEL; ++i) hipLaunchKernelGGL(noop_kernel, dim3(1), dim3(64), 0, stream, (int*)d_ws + 300000);
#endif
    if (hipMemsetAsync((char*)d_ws + WS_CTL, 0, CTL_ZERO_BYTES, stream) != hipSuccess) return;
    Args a{};
    for (int i = 0; i < 10; ++i) a.in[i] = (const float*)d_in[i];
    a.out = (float*)d_out; a.ws = (unsigned char*)d_ws;
    if (MK_CUTS == 1) { a.ph_lo = 0; a.ph_hi = 5; for (int pass = 0; pass < NPASS; ++pass) { if (pass) hipMemsetAsync((char*)d_ws + WS_CTL, 0, CTL_ZERO_BYTES, stream); hipLaunchKernelGGL(hybrid_fwd, dim3(grid), dim3(NWAVES * 64), LDS_BYTES, stream, a); } }
    else for (int p = 0; p < 5; ++p) { a.ph_lo = p; a.ph_hi = p + 1; hipLaunchKernelGGL(hybrid_fwd, dim3(grid), dim3(NWAVES * 64), LDS_BYTES, stream, a); }
}
```

```cpp
#include <hip/hip_runtime.h>
#include <hip/hip_bf16.h>
#include <cstdio>
#include <cstdint>

namespace cfg {
constexpr int BATCH = 16, SEQ = 2048, DM = 1024, M = BATCH * SEQ;
constexpr int NH = 8, HD = 64, W = 512, INW = 6144;
constexpr int MBLK = 256, NBLK = SEQ / MBLK, TOPK = 3;
constexpr float EPS = 1e-6f;
constexpr float LOG2E = 1.4426950408889634f;
constexpr float C2 = 0.125f * LOG2E;
#ifndef SB_EXIT_BITS
#define SB_EXIT_BITS 150
#endif
constexpr float SB_EXIT = (float)SB_EXIT_BITS;
constexpr size_t MiB = 1u << 20;
constexpr size_t WS_CTL = 0, CTL_ZERO_BYTES = 1 * MiB, WS_KSUM = 512 * 1024, WS_SIG = 768 * 1024;
constexpr size_t WS_WIN = 2 * MiB, WS_WUP = 14 * MiB, WS_WOUT = 16 * MiB;
constexpr size_t WS_H = 20 * MiB;
constexpr size_t WS_P = 84 * MiB;
#ifndef GPITCH
#define GPITCH 1024
#endif
constexpr int GP = GPITCH;
constexpr size_t WS_GR = 340 * MiB, WS_GB = 404 * MiB;
constexpr size_t WS_Y = 84 * MiB;
constexpr size_t WS_END = 468 * MiB;
constexpr size_t OPAN = (size_t)512 * 1024;
constexpr int CW_BRDY = 12288;
constexpr int CW_HRDY = 32768, CW_WCNT = 40960;
constexpr int CW_ORDY = 24576;
constexpr int CW_QBAR = 16384;
constexpr int CW_TMO = 0, CW_BAR = 4096, CW_QUEUE = 8192;
}
using namespace cfg;
#define GAS __attribute__((address_space(1)))
#define LAS __attribute__((address_space(3)))

__host__ __device__ __forceinline__ int phys_of_actual(int col) { const int a = col & 255; return (col & ~255) + 128 * ((a >> 5) & 1) + 32 * (a >> 6) + (a & 31); }
__host__ __device__ __forceinline__ int win_row_of_col(int n) { if (n < 4096) return phys_of_actual(n); const int g = n - 4096, which = g >> 10, c = g & 1023; return (16 + (c >> 7)) * 256 + 128 * which + (c & 127); }

__constant__ unsigned char T5B[128] = {0, 1, 2, 3, 4, 5, 6, 7, 8, 9, 10, 11, 12, 13, 14, 15, 16, 16, 16, 17, 17, 18, 18, 18, 19, 19, 19, 20, 20, 20, 20, 21, 21, 21, 21, 22, 22, 22, 22, 22, 23, 23, 23, 23, 23, 23, 24, 24, 24, 24, 24, 24, 25, 25, 25, 25, 25, 25, 25, 26, 26, 26, 26, 26, 26, 26, 26, 27, 27, 27, 27, 27, 27, 27, 27, 27, 27, 28, 28, 28, 28, 28, 28, 28, 28, 28, 28, 29, 29, 29, 29, 29, 29, 29, 29, 29, 29, 29, 29, 30, 30, 30, 30, 30, 30, 30, 30, 30, 30, 30, 30, 30, 30, 31, 31, 31, 31, 31, 31, 31, 31, 31, 31, 31, 31, 31, 31, 31};

namespace pg8 {
#define PG8_LAS __attribute__((address_space(3)))
typedef unsigned short bf16_t;
typedef short bf16x8 __attribute__((ext_vector_type(8)));
typedef float f32x4 __attribute__((ext_vector_type(4)));
typedef unsigned u32x4 __attribute__((ext_vector_type(4)));
constexpr int BM = 256, BK = 64, HALF = 128, HTB = HALF * BK * 2  , STAGE_BYTES = 8 * HTB, NXCD = 8, WGM = 8;

__host__ __device__ __forceinline__ int lds_byte(int r, int c) { const int st = (r >> 4) * 2 + (c >> 5), rr = r & 15, cc = c & 31, ob = rr * 64 + cc * 2; return st * 1024 + (ob ^ (((ob >> 9) & 1) << 5)); }
__host__ __device__ __forceinline__ void stage_rc(int b, int& R, int& C) { const int st = b / 1024, sb = b % 1024, swz = sb ^ (((sb >> 9) & 1) << 5); R = (st >> 1) * 16 + swz / 64; C = (st & 1) * 32 + (swz % 64) / 2; }
__host__ __device__ __forceinline__ int perm32(int rho) { const int n = rho >> 4, i = rho & 15; return 8 * (i >> 2) + 4 * n + (i & 3); }

struct Unit { int pm, pn; };
struct Gemm { const bf16_t* A; const bf16_t* Bt; int M, N, K, lda, ldb; size_t pa, ha; };

struct StaticOrder {
    int nM, nN, nwg, G, c, dup, pnperm, rev;
    __host__ __device__ void init(int M, int N, int G_, int c_, int dup_ = 1, int pnperm_ = 0, int rev_ = 0) { nM = M / BM; nN = N / BM; nwg = nM * nN; G = G_; c = c_; dup = dup_; pnperm = pnperm_; rev = rev_ && (nwg % G_ == 0); }
    __host__ __device__ bool next_skip(int, Unit&) const { return false; }
    __host__ __device__ bool next(int i, Unit& u) const {
        const int R_ = (nwg + G - 1) / G; if (rev && (i / dup) >= R_) return false;
        const long L = (long)(rev ? (R_ - 1 - i / dup) : (i / dup)) * G + c; if (L >= nwg) return rev ? next_skip(i, u) : false;
        int wgid = (int)L; { const int q = nwg / NXCD, r = nwg % NXCD, xcd = wgid % NXCD, off = wgid / NXCD; wgid = (xcd < r ? xcd * (q + 1) : r * (q + 1) + (xcd - r) * q) + off; }
        const int nig = WGM * nN, gid = wgid / nig, fm = gid * WGM, gsz = (nM - fm) < WGM ? (nM - fm) : WGM;
        u.pm = fm + ((wgid % nig) % gsz); u.pn = (wgid % nig) / gsz;
        if (pnperm) u.pn = (u.pn < 8) ? u.pn + 16 : u.pn - 8;
        return true;
    }
    __device__ __forceinline__ void a_ready(const Unit&) const {}
    __device__ __forceinline__ void done(const Unit&) const {}
};


__device__ __forceinline__ unsigned cvt_pk_bf16(float lo, float hi) { unsigned r; asm volatile("v_cvt_pk_bf16_f32 %0, %1, %2" : "=v"(r) : "v"(lo), "v"(hi)); return r; }
__device__ __forceinline__ float sigm(float x) { return __builtin_amdgcn_rcpf(1.0f + __builtin_amdgcn_exp2f(-LOG2E * x)); }
__device__ __forceinline__ u32x4 pack8(const f32x4& a, const f32x4& b) { u32x4 w; w.x = cvt_pk_bf16(a[0], a[1]); w.y = cvt_pk_bf16(a[2], a[3]); w.z = cvt_pk_bf16(b[0], b[1]); w.w = cvt_pk_bf16(b[2], b[3]); return w; }
#ifndef WT_STORES
#define WT_STORES 0
#endif
#ifndef NT_STORES
#define NT_STORES 1
#endif
#ifndef NT_LOADS
#define NT_LOADS 0
#endif
#ifndef G_NTL
#define G_NTL NT_LOADS
#endif
#ifndef X3_NTL
#define X3_NTL NT_LOADS
#endif
#ifndef A_NT2
#define A_NT2 false
#endif
#ifndef A_NT3
#define A_NT3 false
#endif
#ifndef Y_NT
#define Y_NT 0
#endif
#ifndef WARM_GB
#define WARM_GB 0
#endif
#ifndef EPIY_FENCE
#define EPIY_FENCE 0
#endif
__device__ __forceinline__ void st16(void* p, const u32x4& v) {
#if WT_STORES
    asm volatile("global_store_dwordx4 %0, %1, off sc1\n\ts_nop 1" :: "v"(p), "v"(v) : "memory");
#elif NT_STORES
    __builtin_nontemporal_store(v, (u32x4*)p);
#else
    *(u32x4*)p = v;
#endif
}
__device__ __forceinline__ void unpack8(const u32x4& w, f32x4& a, f32x4& b) {
    a[0] = __uint_as_float(w.x << 16); a[1] = __uint_as_float(w.x & 0xffff0000u); a[2] = __uint_as_float(w.y << 16); a[3] = __uint_as_float(w.y & 0xffff0000u);
    b[0] = __uint_as_float(w.z << 16); b[1] = __uint_as_float(w.z & 0xffff0000u); b[2] = __uint_as_float(w.w << 16); b[3] = __uint_as_float(w.w & 0xffff0000u); }

__device__ __forceinline__ void st16p(void* p, const u32x4& v) { *(u32x4*)p = v; }
#ifndef NT_QKVZ
#define NT_QKVZ 1
#endif
struct EpiProj {
    static constexpr bool PERM = true, AFTER_DRAIN = false, MIDK = false; static constexpr int GTID = 1; static constexpr bool A_NT = false;
    unsigned char* ws; const float* gbias; const float* qnw; const float* knw; int nostore;
    __device__ __forceinline__ void mid(f32x4 (&)[2][2][4][2], const Unit&, int, int, int, int) const {}
    __device__ __forceinline__ void operator()(const f32x4 (&acc)[2][2][4][2], const Unit& u, int wr, int wc, int fr, int fq) const {
        const int pn = u.pn; const int row0 = u.pm * BM + wr * 64 + fr;
        if (pn < 16) {
            const int g = pn >> 1;
            bf16_t* base = (bf16_t*)(ws + WS_P + (size_t)g * (32 * MiB)) + (pn & 1) * 256 + wc * 64 + 8 * fq;
            if (g <= 1) {
                const float* nw = (g == 0 ? qnw : knw) + 8 * fq; f32x4 wv[2][2], cs[2][2];
#pragma unroll
                for (int bj = 0; bj < 2; ++bj)
#pragma unroll
                    for (int n = 0; n < 2; ++n) { wv[bj][n] = *(const f32x4*)(nw + 32 * bj + 4 * n); if (g == 0) wv[bj][n] = wv[bj][n] * C2; cs[bj][n] = (f32x4){0.f, 0.f, 0.f, 0.f}; }
#pragma unroll
                for (int ai = 0; ai < 2; ++ai)
#pragma unroll
                    for (int m = 0; m < 4; ++m) { float ss = 0.f;
#pragma unroll
                        for (int bj = 0; bj < 2; ++bj)
#pragma unroll
                            for (int n = 0; n < 2; ++n) { const f32x4 x = acc[ai][bj][m][n]; ss += (x[0] * x[0] + x[1] * x[1]) + (x[2] * x[2] + x[3] * x[3]); }
                        ss += __shfl_xor(ss, 16); ss += __shfl_xor(ss, 32);
                        const float rstd = __builtin_amdgcn_rsqf(ss * (1.0f / 64.0f) + EPS);
                        bf16_t* rowp = base + (size_t)(row0 + ai * HALF + m * 16) * W;
#pragma unroll
                        for (int bj = 0; bj < 2; ++bj) { const f32x4 v0 = acc[ai][bj][m][0] * rstd * wv[bj][0], v1 = acc[ai][bj][m][1] * rstd * wv[bj][1];
                            if (g == 1) { cs[bj][0] += v0; cs[bj][1] += v1; }
                            if (!nostore) { if (NT_QKVZ) st16(rowp + bj * 32, pack8(v0, v1)); else st16p(rowp + bj * 32, pack8(v0, v1)); } } }
                if (g == 1) {
                    float* ks = (float*)(ws + WS_KSUM) + ((size_t)((u.pm >> 3) * NH + (pn & 1) * 4 + wc) * NBLK + (u.pm & 7)) * 64 + 8 * fq;
#pragma unroll
                    for (int bj = 0; bj < 2; ++bj)
#pragma unroll
                        for (int n = 0; n < 2; ++n)
#pragma unroll
                            for (int e = 0; e < 4; ++e) { float x = cs[bj][n][e]; x += __shfl_xor(x, 1); x += __shfl_xor(x, 2); x += __shfl_xor(x, 4); x += __shfl_xor(x, 8);
                                if (fr == 0 && !nostore) atomicAdd(ks + 32 * bj + 4 * n + e, x); }
                }
            } else {
                const bool silu = (g == 3) || (g == 7); const float sc = (g == 4) ? C2 : 1.0f;
#pragma unroll
                for (int ai = 0; ai < 2; ++ai)
#pragma unroll
                    for (int m = 0; m < 4; ++m) { bf16_t* rowp = base + (size_t)(row0 + ai * HALF + m * 16) * W;
#pragma unroll
                        for (int bj = 0; bj < 2; ++bj) { f32x4 v0 = acc[ai][bj][m][0] * sc, v1 = acc[ai][bj][m][1] * sc;
                            if (silu) {
#pragma unroll
                                for (int e = 0; e < 4; ++e) { v0[e] = v0[e] * sigm(v0[e]); v1[e] = v1[e] * sigm(v1[e]); } }
                            if (!nostore) { if (NT_QKVZ) st16(rowp + bj * 32, pack8(v0, v1)); else st16p(rowp + bj * 32, pack8(v0, v1)); } } }
            }
        } else {
            const int gc = 128 * (pn - 16) + 32 * wc + 8 * fq; f32x4 ba[2], bb[2];
#pragma unroll
            for (int n = 0; n < 2; ++n) { ba[n] = *(const f32x4*)(gbias + gc + 4 * n) * (-LOG2E); bb[n] = *(const f32x4*)(gbias + DM + gc + 4 * n) * (-LOG2E); }
            bf16_t* gr = (bf16_t*)(ws + WS_GR) + gc; bf16_t* gbp = (bf16_t*)(ws + WS_GB) + gc;
#pragma unroll
            for (int ai = 0; ai < 2; ++ai)
#pragma unroll
                for (int m = 0; m < 4; ++m) { const size_t ro = (size_t)(row0 + ai * HALF + m * 16) * GP; f32x4 r[2], b[2];
#pragma unroll
                    for (int n = 0; n < 2; ++n)
#pragma unroll
                        for (int e = 0; e < 4; ++e) {
                            const float A = 1.0f + __builtin_amdgcn_exp2f(__builtin_fmaf(acc[ai][0][m][n][e], -LOG2E, ba[n][e])), B = 1.0f + __builtin_amdgcn_exp2f(__builtin_fmaf(acc[ai][1][m][n][e], -LOG2E, bb[n][e]));
                            b[n][e] = __builtin_fmaxf(__builtin_amdgcn_rcpf(B), 9.5367431640625e-07f); r[n][e] = __builtin_amdgcn_rcpf(A) * __builtin_fminf(B, 1048576.0f); }
                    if (!nostore) { st16(gr + ro, pack8(r[0], r[1])); st16(gbp + ro, pack8(b[0], b[1])); } }
        }
    }
};
struct EpiY {
    static constexpr bool PERM = true, AFTER_DRAIN = false, MIDK = true; static constexpr int GTID = 2; static constexpr bool A_NT = A_NT2;
    const bf16_t* GR; const bf16_t* GB; bf16_t* Y; PG8_LAS unsigned* dummy; bf16_t* Y1; size_t ypan;
    __device__ __forceinline__ void mid(f32x4 (&acc)[2][2][4][2], const Unit& u, int wr, int wc, int fr, int fq) const {
        unsigned lo = (unsigned)(fr * GP + 8 * fq); asm volatile("" : "+v"(lo));
        const bf16_t* p = GR + (size_t)(u.pm * BM + wr * 64) * GP + u.pn * BM + wc * 64 + lo;
#if WARM_GB
        { const bf16_t* q = GB + (size_t)(u.pm * BM + wr * 64) * GP + u.pn * BM + wc * 64 + lo;
#pragma unroll
          for (int ai = 0; ai < 2; ++ai)
#pragma unroll
            for (int m = 0; m < 4; ++m)
#pragma unroll
                for (int bj = 0; bj < 2; ++bj) __builtin_amdgcn_global_load_lds((const unsigned*)(q + (size_t)(ai * HALF + m * 16) * GP + bj * 32), dummy, 16, 0, 0); }
#endif
        u32x4 gv[2][4][2];
#pragma unroll
        for (int ai = 0; ai < 2; ++ai)
#pragma unroll
            for (int m = 0; m < 4; ++m)
#pragma unroll
                for (int bj = 0; bj < 2; ++bj) gv[ai][m][bj] = *(const u32x4*)(p + (size_t)(ai * HALF + m * 16) * GP + bj * 32);
        asm volatile("" ::: "memory");
#pragma unroll
        for (int ai = 0; ai < 2; ++ai)
#pragma unroll
            for (int m = 0; m < 4; ++m)
#pragma unroll
                for (int bj = 0; bj < 2; ++bj) { f32x4 a, b; unpack8(gv[ai][m][bj], a, b); acc[ai][bj][m][0] = acc[ai][bj][m][0] * a; acc[ai][bj][m][1] = acc[ai][bj][m][1] * b; }
    }
    __device__ __forceinline__ void operator()(const f32x4 (&acc)[2][2][4][2], const Unit& u, int wr, int wc, int fr, int fq) const {
        unsigned lo = (unsigned)(fr * DM + 8 * fq), lg = (unsigned)(fr * GP + 8 * fq); asm volatile("" : "+v"(lo), "+v"(lg));
        const size_t o0 = (size_t)u.pm * ypan + (size_t)(wr * 64) * DM + u.pn * BM + wc * 64 + lo, g0 = (size_t)(u.pm * BM + wr * 64) * GP + u.pn * BM + wc * 64 + lg;
        u32x4 gv[2][4][2];
#pragma unroll
        for (int ai = 0; ai < 2; ++ai)
#pragma unroll
            for (int m = 0; m < 4; ++m)
#pragma unroll
                for (int bj = 0; bj < 2; ++bj) gv[ai][m][bj] = *(const u32x4*)(GB + g0 + (size_t)(ai * HALF + m * 16) * GP + bj * 32);
        asm volatile("" ::: "memory");
#pragma unroll
        for (int ai = 0; ai < 2; ++ai)
#pragma unroll
            for (int m = 0; m < 4; ++m)
#pragma unroll
                for (int bj = 0; bj < 2; ++bj) { const size_t o = o0 + (size_t)(m * 16) * DM + bj * 32; f32x4 a, b; unpack8(gv[ai][m][bj], a, b); bf16_t* const Yh = ai ? Y1 : Y;
                    if (Y_NT) st16(Yh + o, pack8(acc[ai][bj][m][0] * a, acc[ai][bj][m][1] * b)); else st16p(Yh + o, pack8(acc[ai][bj][m][0] * a, acc[ai][bj][m][1] * b)); }
    }
};
#ifndef NT_OUT
#define NT_OUT 1
#endif
#ifndef H3_NTL
#define H3_NTL 0
#endif
struct EpiOut {
    static constexpr bool PERM = true, AFTER_DRAIN = false, MIDK = false; static constexpr int GTID = 3; static constexpr bool A_NT = A_NT3;
    const float* X; float* OUT; const bf16_t* HB; const float* SIG; const float* NW; int useh;
    __device__ __forceinline__ void mid(f32x4 (&)[2][2][4][2], const Unit&, int, int, int, int) const {}
    __device__ __forceinline__ void operator()(const f32x4 (&acc)[2][2][4][2], const Unit& u, int wr, int wc, int fr, int fq) const {
        const size_t o0 = (size_t)(u.pm * BM + wr * 64 + fr) * DM + u.pn * BM + wc * 64 + 8 * fq;
        if (useh) {
            f32x4 wi[2][2];
#pragma unroll
            for (int bj = 0; bj < 2; ++bj)
#pragma unroll
                for (int n = 0; n < 2; ++n) { const f32x4 w_ = *(const f32x4*)(NW + u.pn * BM + wc * 64 + 8 * fq + bj * 32 + 4 * n);
#pragma unroll
                    for (int e = 0; e < 4; ++e) wi[bj][n][e] = __builtin_amdgcn_rcpf(w_[e]); }
            u32x4 hv[2][4][2]; float sg[2][4];
#pragma unroll
            for (int ai = 0; ai < 2; ++ai)
#pragma unroll
                for (int m = 0; m < 4; ++m) { sg[ai][m] = SIG[u.pm * BM + wr * 64 + fr + ai * HALF + m * 16];
#pragma unroll
                    for (int bj = 0; bj < 2; ++bj) hv[ai][m][bj] = H3_NTL ? __builtin_nontemporal_load((const u32x4*)(HB + o0 + (size_t)(ai * HALF + m * 16) * DM + bj * 32)) : *(const u32x4*)(HB + o0 + (size_t)(ai * HALF + m * 16) * DM + bj * 32); }
            asm volatile("" ::: "memory");
#pragma unroll
            for (int ai = 0; ai < 2; ++ai)
#pragma unroll
                for (int m = 0; m < 4; ++m)
#pragma unroll
                    for (int bj = 0; bj < 2; ++bj) { const size_t o = o0 + (size_t)(ai * HALF + m * 16) * DM + bj * 32; f32x4 a, b_; unpack8(hv[ai][m][bj], a, b_);
                        const f32x4 r0_ = a * (wi[bj][0] * sg[ai][m]) + acc[ai][bj][m][0], r1_ = b_ * (wi[bj][1] * sg[ai][m]) + acc[ai][bj][m][1];
                        if (NT_OUT) { __builtin_nontemporal_store(r0_, (f32x4*)(OUT + o)); __builtin_nontemporal_store(r1_, (f32x4*)(OUT + o + 4)); } else { *(f32x4*)(OUT + o) = r0_; *(f32x4*)(OUT + o + 4) = r1_; } }
            return;
        }
#pragma unroll
        for (int ai = 0; ai < 2; ++ai) {
            f32x4 xv[4][2][2];
#pragma unroll
            for (int m = 0; m < 4; ++m)
#pragma unroll
                for (int bj = 0; bj < 2; ++bj) { const size_t o = o0 + (size_t)(ai * HALF + m * 16) * DM + bj * 32; xv[m][bj][0] = *(const f32x4*)(X + o); xv[m][bj][1] = *(const f32x4*)(X + o + 4); }
            asm volatile("" ::: "memory");
#pragma unroll
            for (int m = 0; m < 4; ++m)
#pragma unroll
                for (int bj = 0; bj < 2; ++bj) { const size_t o = o0 + (size_t)(ai * HALF + m * 16) * DM + bj * 32;
                    *(f32x4*)(OUT + o) = xv[m][bj][0] + acc[ai][bj][m][0]; *(f32x4*)(OUT + o + 4) = xv[m][bj][1] + acc[ai][bj][m][1]; }
        }
    }
};

#ifdef GT_PROBE
#define GTS(k) do { if (blockIdx.x == 0 && threadIdx.x == 0 && Epi::GTID == GT_PHASE) { volatile PG8_LAS unsigned long long* u_ = (volatile PG8_LAS unsigned long long*)(lds + 132160); if (u_[7] == (unsigned long long)GT_UNIT) u_[k] = __builtin_amdgcn_s_memrealtime(); if ((k) == 2) u_[7] = u_[7] + 1ull; } } while (0)
#else
#define GTS(k) do {} while (0)
#endif
template <class Epi, class Sched, bool ALIGN_EPI = false, bool SP2 = false>
__device__ __forceinline__ void gemm_phase(PG8_LAS unsigned char* lds, const Gemm g, const Sched& S, const Epi& E) {
    const int tid = threadIdx.x, wid = __builtin_amdgcn_readfirstlane(tid >> 6), lane = tid & 63, wr = wid >> 2, wc = wid & 3, fr = lane & 15, fq = lane >> 4;
    const int K = g.K, nt = K / BK;
    unsigned voffA[2], voffB[2];
#pragma unroll
    for (int i = 0; i < 2; ++i) { int R, C; stage_rc(tid * 16 + i * 8192, R, C); const int Rb = Epi::PERM ? ((R & ~31) + perm32(R & 31)) : R;
        voffA[i] = (unsigned)(R * g.lda + C) * 2u; voffB[i] = (unsigned)(Rb * g.ldb + C) * 2u; }
    const size_t kstep = (size_t)(BK * 2);
    const size_t hA = g.ha ? g.ha : (size_t)HALF * g.lda * 2, hB = (size_t)HALF * g.ldb * 2;
    const size_t tA = g.pa ? g.pa : (size_t)BM * g.lda * 2, tB = 2 * hB;
    const unsigned ldsw = (unsigned)wid * 1024u;
    const int aoff = lds_byte(wr * 64 + fr, fq * 8), boff = lds_byte(wc * 32 + fr, fq * 8);
#define PG8_SA(b, h) (((b) * 2 + (h)) * HTB)
#define PG8_SB(b, h) ((4 + (b) * 2 + (h)) * HTB)
#define PG8_STAGE(bufoff, gbase, voff) do { _Pragma("unroll") for (int _i = 0; _i < 2; ++_i) { \
        if constexpr (Epi::A_NT && ((bufoff) < 4 * HTB)) __builtin_amdgcn_global_load_lds((const unsigned*)((const char*)(gbase) + (voff)[_i]), (PG8_LAS unsigned*)(lds + (bufoff) + ldsw + _i * 8192), 16, 0, 2);     \
        else __builtin_amdgcn_global_load_lds((const unsigned*)((const char*)(gbase) + (voff)[_i]), (PG8_LAS unsigned*)(lds + (bufoff) + ldsw + _i * 8192), 16, 0, 0); } } while (0)
#define PG8_LDA(dst, b, h) do { _Pragma("unroll") for (int m = 0; m < 4; ++m) _Pragma("unroll") for (int k = 0; k < 2; ++k) dst[m][k] = *(const PG8_LAS bf16x8*)(lds + PG8_SA(b, h) + aoff + m * 2048 + k * 1024); } while (0)
#define PG8_LDB(dst, b, h) do { _Pragma("unroll") for (int n = 0; n < 2; ++n) _Pragma("unroll") for (int k = 0; k < 2; ++k) dst[n][k] = *(const PG8_LAS bf16x8*)(lds + PG8_SB(b, h) + boff + n * 2048 + k * 1024); } while (0)
#define PG8_MMA(ai, bj, At, Bt) do { __builtin_amdgcn_s_setprio(1); _Pragma("unroll") for (int m = 0; m < 4; ++m) _Pragma("unroll") for (int n = 0; n < 2; ++n) _Pragma("unroll") for (int k = 0; k < 2; ++k) \
        acc[ai][bj][m][n] = __builtin_amdgcn_mfma_f32_16x16x32_bf16(Bt[n][k], At[m][k], acc[ai][bj][m][n], 0, 0, 0); __builtin_amdgcn_s_setprio(0); } while (0)
#define PG8_WAIT_V(n) asm volatile("s_waitcnt vmcnt(" #n ")" ::: "memory")
#define PG8_WAIT_L(n) asm volatile("s_waitcnt lgkmcnt(" #n ")" ::: "memory")
#define PG8_BAR __builtin_amdgcn_s_barrier()
#define PG8_SCHED __builtin_amdgcn_sched_barrier(0)
    Unit cur, nxt; int ui = 0;
    if (!S.next(0, cur)) return;
    f32x4 acc[2][2][4][2];
#pragma unroll
    for (int a = 0; a < 2; ++a)
#pragma unroll
        for (int b = 0; b < 2; ++b)
#pragma unroll
            for (int m = 0; m < 4; ++m)
#pragma unroll
                for (int n = 0; n < 2; ++n) acc[a][b][m][n] = (f32x4){0.f, 0.f, 0.f, 0.f};
    bf16x8 At[4][2], B0[2][2], B1[2][2];
    const char* cA = (const char*)g.A + (size_t)cur.pm * tA; const char* cB = (const char*)g.Bt + (size_t)cur.pn * tB;
    S.a_ready(cur);
    if constexpr (SP2) {
        PG8_STAGE(PG8_SB(0, 0), cB, voffB); PG8_STAGE(PG8_SB(0, 1), cB + hB, voffB); PG8_STAGE(PG8_SA(0, 0), cA, voffA); PG8_STAGE(PG8_SA(0, 1), cA + hA, voffA);
        if (wr == 1) PG8_BAR;
        PG8_WAIT_V(2); PG8_BAR;
        PG8_STAGE(PG8_SB(1, 0), cB + kstep, voffB); PG8_STAGE(PG8_SA(1, 0), cA + kstep, voffA); PG8_STAGE(PG8_SB(1, 1), cB + hB + kstep, voffB);
        PG8_WAIT_V(6); PG8_BAR;
    } else {
        PG8_STAGE(PG8_SB(0, 0), cB, voffB); PG8_STAGE(PG8_SA(0, 0), cA, voffA); PG8_STAGE(PG8_SB(0, 1), cB + hB, voffB); PG8_STAGE(PG8_SA(0, 1), cA + hA, voffA);
        if (wr == 1) PG8_BAR;
        PG8_WAIT_V(4); PG8_BAR;
        PG8_STAGE(PG8_SB(1, 0), cB + kstep, voffB); PG8_STAGE(PG8_SA(1, 0), cA + kstep, voffA); PG8_STAGE(PG8_SB(1, 1), cB + hB + kstep, voffB);
        PG8_WAIT_V(6); PG8_BAR;
    }
    for (;;) {
        const bool has_next = S.next(ui + 1, nxt);
        const char* nA = has_next ? (const char*)g.A + (size_t)nxt.pm * tA : cA; const char* nB = has_next ? (const char*)g.Bt + (size_t)nxt.pn * tB : cB;
        GTS(0);
        constexpr int NH = Epi::MIDK ? 2 : 1;
#pragma unroll 1
        for (int hh = 0; hh < NH; ++hh) {
        if constexpr (Epi::MIDK) { if (hh == 1) { int fr_ = fr, fq_ = fq; asm volatile("" : "+v"(fr_), "+v"(fq_)); E.mid(acc, cur, wr, wc, fr_, fq_); } }
#pragma unroll 1
        for (int t = hh * (nt / NH); t < (hh + 1) * (nt / NH); t += 2) {
            const bool last = (t == nt - 2);
            const char* a1 = cA + (size_t)(t + 1) * kstep;
            const char* a2 = last ? nA : cA + (size_t)(t + 2) * kstep; const char* b2 = last ? nB : cB + (size_t)(t + 2) * kstep;
            const char* a3 = a2 + kstep; const char* b3 = b2 + kstep;
            if (last && has_next) S.a_ready(nxt);
            if constexpr (SP2) {
            PG8_LDB(B0, 0, 0); PG8_LDB(B1, 0, 1); PG8_SCHED; PG8_LDA(At, 0, 0); PG8_STAGE(PG8_SA(1, 1), a1 + hA, voffA);
            PG8_WAIT_V(8); PG8_WAIT_L(0); PG8_BAR; PG8_MMA(0, 0, At, B0); PG8_MMA(0, 1, At, B1); PG8_BAR; PG8_SCHED;
            PG8_LDA(At, 0, 1); PG8_STAGE(PG8_SB(0, 0), b2, voffB); PG8_STAGE(PG8_SB(0, 1), b2 + hB, voffB); PG8_STAGE(PG8_SA(0, 0), a2, voffA);
            PG8_WAIT_V(8); PG8_WAIT_L(0); PG8_BAR; PG8_MMA(1, 0, At, B0); PG8_MMA(1, 1, At, B1); PG8_BAR; PG8_SCHED;
            PG8_LDB(B0, 1, 0); PG8_LDB(B1, 1, 1); PG8_SCHED; PG8_LDA(At, 1, 0); PG8_STAGE(PG8_SA(0, 1), a2 + hA, voffA);
            PG8_WAIT_V(8); PG8_WAIT_L(0); PG8_BAR; PG8_MMA(0, 0, At, B0); PG8_MMA(0, 1, At, B1); PG8_BAR; PG8_SCHED;
            PG8_LDA(At, 1, 1); PG8_STAGE(PG8_SB(1, 0), b3, voffB); PG8_STAGE(PG8_SB(1, 1), b3 + hB, voffB); PG8_STAGE(PG8_SA(1, 0), a3, voffA);
            PG8_WAIT_V(8); PG8_WAIT_L(0); PG8_BAR; PG8_MMA(1, 0, At, B0); PG8_MMA(1, 1, At, B1); PG8_BAR; PG8_SCHED;
            } else {
            PG8_LDB(B0, 0, 0); PG8_SCHED; PG8_LDA(At, 0, 0); PG8_STAGE(PG8_SA(1, 1), a1 + hA, voffA);
            PG8_WAIT_L(8); PG8_BAR; PG8_WAIT_L(0); PG8_MMA(0, 0, At, B0); PG8_BAR; PG8_SCHED;
            PG8_LDB(B1, 0, 1); PG8_STAGE(PG8_SB(0, 0), b2, voffB);
            PG8_BAR; PG8_WAIT_L(0); PG8_MMA(0, 1, At, B1); PG8_BAR;
            PG8_LDA(At, 0, 1); PG8_STAGE(PG8_SA(0, 0), a2, voffA);
            PG8_BAR; PG8_WAIT_L(0); PG8_MMA(1, 0, At, B0); PG8_BAR; PG8_SCHED;
            PG8_STAGE(PG8_SB(0, 1), b2 + hB, voffB);
            PG8_WAIT_V(6); PG8_BAR; PG8_MMA(1, 1, At, B1); PG8_BAR;
            PG8_LDB(B0, 1, 0); PG8_SCHED; PG8_LDA(At, 1, 0); PG8_STAGE(PG8_SA(0, 1), a2 + hA, voffA);
            PG8_WAIT_L(8); PG8_BAR; PG8_WAIT_L(0); PG8_MMA(0, 0, At, B0); PG8_BAR; PG8_SCHED;
            PG8_LDB(B1, 1, 1); PG8_STAGE(PG8_SB(1, 0), b3, voffB);
            PG8_BAR; PG8_WAIT_L(0); PG8_MMA(0, 1, At, B1); PG8_BAR;
            PG8_LDA(At, 1, 1); PG8_STAGE(PG8_SA(1, 0), a3, voffA);
            PG8_BAR; PG8_WAIT_L(0); PG8_MMA(1, 0, At, B0); PG8_BAR; PG8_SCHED;
            PG8_STAGE(PG8_SB(1, 1), b3 + hB, voffB);
            PG8_WAIT_V(6); PG8_BAR; PG8_MMA(1, 1, At, B1); PG8_BAR;
            }
        }
        }
        if constexpr (ALIGN_EPI) { if (wr == 0) PG8_BAR; }
        GTS(1);
        if constexpr (!Epi::AFTER_DRAIN) { int fr_ = fr, fq_ = fq; asm volatile("" : "+v"(fr_), "+v"(fq_));
            E(acc, cur, wr, wc, fr_, fq_);
#ifdef EPI2
            asm volatile("" : "+v"(fr_), "+v"(fq_)); E(acc, cur, wr, wc, fr_, fq_);
#endif
            S.done(cur); }
        GTS(2);
        if (!has_next) break;
#pragma unroll
        for (int a = 0; a < 2; ++a)
#pragma unroll
            for (int b = 0; b < 2; ++b)
#pragma unroll
                for (int m = 0; m < 4; ++m)
#pragma unroll
                    for (int n = 0; n < 2; ++n) acc[a][b][m][n] = (f32x4){0.f, 0.f, 0.f, 0.f};
        cur = nxt; cA = nA; cB = nB; ++ui;
        if constexpr (ALIGN_EPI) { if (wr == 1) PG8_BAR; }
    }
    PG8_WAIT_V(0);
    if constexpr (!ALIGN_EPI) { if (wr == 0) PG8_BAR; }
    PG8_BAR;
    if constexpr (Epi::AFTER_DRAIN) { E.fused(acc, cur, wr, wc, fr, fq, lds, wid, lane); S.done(cur); }
#undef PG8_SA
#undef PG8_SB
#undef PG8_STAGE
#undef PG8_LDA
#undef PG8_LDB
#undef PG8_MMA
#undef PG8_WAIT_V
#undef PG8_WAIT_L
#undef PG8_BAR
#undef PG8_SCHED
}
}

#ifndef PG8_SP2
#define PG8_SP2 true
#endif
#ifndef PG8_ALIGN
#define PG8_ALIGN true
#endif

#ifndef O_NT
#define O_NT 1
#endif
#ifndef Q_NTL
#define Q_NTL 0
#endif
#ifndef QORDER
#define QORDER 1
#endif
#ifndef YPRIO
#define YPRIO 1
#endif
#ifndef RO_NTL
#define RO_NTL 0
#endif
#ifndef SBPRIO
#define SBPRIO 1
#endif
namespace attn {
using bf16 = unsigned short;
using bf16x8 = __attribute__((ext_vector_type(8))) short;
using f16x8 = __attribute__((ext_vector_type(8))) _Float16;
using s16x4 = __attribute__((ext_vector_type(4))) short;
using f32x16 = __attribute__((ext_vector_type(16))) float;
using f32x4 = __attribute__((ext_vector_type(4))) float;
using u32x4 = __attribute__((ext_vector_type(4))) unsigned;
typedef LAS const char* lds_cptr;
constexpr int NW = 8, QBLK = 32, QB = 256, KVBLK = 64, PITCH = W, OPITCH = DM;
constexpr int SLOTB = 8192;
constexpr int NSLOT = 3;
constexpr int LDS_K = 0, LDS_V = NSLOT * SLOTB, LDS_WS = 2 * NSLOT * SLOTB, LDS_TAB = LDS_WS + NW * 256, LDS_FLAG = LDS_TAB + 1024, LDS_OST = LDS_FLAG + 1024, LDS_ZST = LDS_OST + NW * 4096, LDS_BYTES = LDS_ZST + NW * 4096;
constexpr int LDS_KSN = LDS_BYTES;
__device__ __forceinline__ int crow(int r, int hi) { return (r & 3) + 8 * (r >> 2) + 4 * hi; }
#define SBAR() __builtin_amdgcn_sched_barrier(0)
#ifdef UT_PROBE
#ifndef UT_UNIT
#define UT_UNIT 0
#endif
#define UTS(k) do { if (blockIdx.x == 0 && threadIdx.x == 0) { volatile LAS unsigned long long* u_ = (volatile LAS unsigned long long*)(shm + 132096); if (u_[7] == (unsigned long long)UT_UNIT) u_[k] = __builtin_amdgcn_s_memrealtime(); if ((k) == 4) u_[7] = u_[7] + 1ull; } } while (0)
#else
#define UTS(k) do {} while (0)
#endif
#ifdef UT_PROBE
#ifndef UT_SUNIT
#define UT_SUNIT 0
#endif
#define SBT(k) do { if (blockIdx.x == 0 && threadIdx.x == 0) { volatile LAS unsigned long long* u_ = (volatile LAS unsigned long long*)(lds + 132224); if (u_[7] == (unsigned long long)UT_SUNIT) u_[k] = __builtin_amdgcn_s_memrealtime(); if ((k) == 4) u_[7] = u_[7] + 1ull; } } while (0)
#else
#define SBT(k) do {} while (0)
#endif
#define WAIT_BAR0() asm volatile("s_waitcnt vmcnt(0) lgkmcnt(0)\n\ts_barrier" ::: "memory")
__device__ __forceinline__ void glds16(const void* gsrc, unsigned lds_dst) { unsigned keep;
    asm volatile("s_mov_b32 %0, m0\n\ts_mov_b32 m0, %2\n\ts_nop 0\n\tglobal_load_lds_dwordx4 %1, off\n\ts_mov_b32 m0, %0" : "=&s"(keep) : "v"(gsrc), "s"(lds_dst) : "memory"); }
__device__ __forceinline__ unsigned cvtpk(float lo, float hi) { typedef float f2 __attribute__((ext_vector_type(2))); typedef __bf16 b2 __attribute__((ext_vector_type(2))); f2 v = {lo, hi}; b2 b = __builtin_convertvector(v, b2); return __builtin_bit_cast(unsigned, b); }
__device__ __forceinline__ unsigned cvtpk_h(float lo, float hi) { typedef float f2 __attribute__((ext_vector_type(2))); typedef _Float16 h2 __attribute__((ext_vector_type(2))); f2 v = {lo, hi}; h2 b = __builtin_convertvector(v, h2); return __builtin_bit_cast(unsigned, b); }
#define MX3(a, b, c) __builtin_fmaxf(__builtin_fmaxf((a), (b)), (c))
__device__ __forceinline__ float rowmax(const f32x16& p0, const f32x16& p1) {
    float a = MX3(p0[0], p0[1], p1[0]), b = MX3(p0[2], p0[3], p1[1]); a = MX3(a, p1[2], p1[3]);
#pragma unroll
    for (int r = 4; r < 16; r += 4) { a = MX3(a, p0[r], p0[r + 1]); b = MX3(b, p0[r + 2], p0[r + 3]); a = MX3(a, p1[r], p1[r + 1]); b = MX3(b, p1[r + 2], p1[r + 3]); }
    float m = __builtin_fmaxf(a, b); auto rr = __builtin_amdgcn_permlane32_swap(__float_as_uint(m), __float_as_uint(m), false, false);
    return __builtin_fmaxf(__uint_as_float(rr[0]), __uint_as_float(rr[1])); }
__device__ __forceinline__ float lowhalf(float v) { auto rr = __builtin_amdgcn_permlane32_swap(__float_as_uint(v), __float_as_uint(v), false, false); return __uint_as_float(rr[0]); }
__device__ __forceinline__ float fadd_s(float a, float b) { float r; asm("v_add_f32_e32 %0, %1, %2" : "=v"(r) : "v"(a), "v"(b)); return r; }
__device__ __forceinline__ float fsub_s(float a, float b) { float r; asm("v_sub_f32_e32 %0, %1, %2" : "=v"(r) : "v"(a), "v"(b)); return r; }
__device__ __forceinline__ unsigned cvtpk_s(float lo, float hi) { return cvtpk(lo, hi); }
typedef short v4i16_t __attribute__((ext_vector_type(4)));
__device__ __forceinline__ void kload8(bf16x8* kf, lds_cptr kp) {
    kf[0] = *(const LAS bf16x8*)(kp);        kf[1] = *(const LAS bf16x8*)(kp + 512);
    kf[2] = *(const LAS bf16x8*)(kp + 2048); kf[3] = *(const LAS bf16x8*)(kp + 2560);
    kf[4] = *(const LAS bf16x8*)(kp + 4096); kf[5] = *(const LAS bf16x8*)(kp + 4608);
    kf[6] = *(const LAS bf16x8*)(kp + 6144); kf[7] = *(const LAS bf16x8*)(kp + 6656); }
__device__ __forceinline__ void kload2(bf16x8* kf, lds_cptr kp, int j) { kf[2 * j] = *(const LAS bf16x8*)(kp + j * 2048); kf[2 * j + 1] = *(const LAS bf16x8*)(kp + j * 2048 + 512); }
__device__ __forceinline__ s16x4 vtr(lds_cptr p) { return __builtin_bit_cast(s16x4, __builtin_amdgcn_ds_read_tr16_b64_v4i16((LAS v4i16_t*)p)); }
__device__ __forceinline__ void qkt(f32x16& p0, f32x16& p1, lds_cptr Kslot, const bf16x8* qr, const f32x16& c0, int r32, int hi) {
    const lds_cptr kb = Kslot + hi * 1024 + r32 * 16;
#pragma unroll
    for (int d0 = 0; d0 < 4; ++d0) {
        const bf16x8 b0 = *(const LAS bf16x8*)(kb + d0 * 2048);
        const bf16x8 b1 = *(const LAS bf16x8*)(kb + d0 * 2048 + 512);
        if (d0 == 0) { p0 = __builtin_amdgcn_mfma_f32_32x32x16_bf16(b0, qr[0], c0, 0, 0, 0); p1 = __builtin_amdgcn_mfma_f32_32x32x16_bf16(b1, qr[0], c0, 0, 0, 0); }
        else { p0 = __builtin_amdgcn_mfma_f32_32x32x16_bf16(b0, qr[d0], p0, 0, 0, 0); p1 = __builtin_amdgcn_mfma_f32_32x32x16_bf16(b1, qr[d0], p1, 0, 0, 0); } }
}
__device__ __forceinline__ void pv(f32x16* o, int vb, bf16x8 pa0, bf16x8 pa1, bf16x8 pa2, bf16x8 pa3) {
#pragma unroll
    for (int d0 = 0; d0 < 2; ++d0) { s16x4 lo[4], hi[4];
#pragma unroll
        for (int ks = 0; ks < 4; ++ks) {
            asm volatile("ds_read_b64_tr_b16 %0,%1 offset:%c2" : "=&v"(lo[ks]) : "v"(vb), "i"(d0 * 4096 + ks * 1024) : "memory");
            asm volatile("ds_read_b64_tr_b16 %0,%1 offset:%c2" : "=&v"(hi[ks]) : "v"(vb), "i"(d0 * 4096 + ks * 1024 + 512) : "memory"); }
        asm volatile("s_waitcnt lgkmcnt(0)" ::: "memory"); SBAR();
#define PK(k) (bf16x8){lo[k][0], lo[k][1], lo[k][2], lo[k][3], hi[k][0], hi[k][1], hi[k][2], hi[k][3]}
        o[d0] = __builtin_amdgcn_mfma_f32_32x32x16_bf16(pa0, PK(0), o[d0], 0, 0, 0);
        o[d0] = __builtin_amdgcn_mfma_f32_32x32x16_bf16(pa1, PK(1), o[d0], 0, 0, 0);
        o[d0] = __builtin_amdgcn_mfma_f32_32x32x16_bf16(pa2, PK(2), o[d0], 0, 0, 0);
        o[d0] = __builtin_amdgcn_mfma_f32_32x32x16_bf16(pa3, PK(3), o[d0], 0, 0, 0);
#undef PK
    }
}
#define PKW(P, B) cvtpk(P[B], P[B + 1])
__device__ __forceinline__ void store_gated(const f32x16* o, const float* rsc  , LAS char* stage, const u32x4* zr  , bf16* Ow, int lane, int r32, int hi) {
    LAS bf16* stg = (LAS bf16*)stage;
#pragma unroll
    for (int r = 0; r < 16; ++r) { const int orow = crow(r, hi); const float s = rsc ? rsc[r] : 1.0f;
#pragma unroll
        for (int d0 = 0; d0 < 2; ++d0) { const float v = o[d0][r] * s; const unsigned u = cvtpk(v, v); stg[orow * 64 + d0 * 32 + r32] = (bf16)(u & 0xffffu); } }
    asm volatile("s_waitcnt lgkmcnt(0)" ::: "memory");
#pragma unroll
    for (int i = 0; i < 4; ++i) { const int row = i * 8 + (lane >> 3), ch = lane & 7; const u32x4 v = *(const LAS u32x4*)(stg + row * 64 + ch * 8); const u32x4 z = zr[i];
        u32x4 w;
#pragma unroll
        for (int k = 0; k < 4; ++k) { const float a0 = __uint_as_float(v[k] << 16) * __uint_as_float(z[k] << 16), a1 = __uint_as_float(v[k] & 0xffff0000u) * __uint_as_float(z[k] & 0xffff0000u); w[k] = cvtpk(a0, a1); }
        if (O_NT) __builtin_nontemporal_store(w, (u32x4*)(Ow + (size_t)row * OPITCH + ch * 8)); else *(u32x4*)(Ow + (size_t)row * OPITCH + ch * 8) = w; }
}

__device__ __forceinline__ void moba_tables(LAS float* tabs, const float* rel_bias  , int tid) {
    for (int e = tid; e < NH * 130; e += NW * 64) { const int hh = e / 130, i = e % 130; tabs[hh * 132 + i] = (i == 0) ? -1e30f : (i < 129 ? (rel_bias[hh * 32 + T5B[i - 1]] - rel_bias[hh * 32 + 31]) * LOG2E : 0.f); }
}
__device__ __forceinline__ void moba_ksum_load(f32x4 (&ks)[8], const float* ksum, int r32, int hi) {
#pragma unroll
    for (int d0 = 0; d0 < 4; ++d0) { const float* kp = ksum + (r32 & 7) * 64 + d0 * 16 + hi * 8; ks[2 * d0] = *(const f32x4*)kp; ks[2 * d0 + 1] = *(const f32x4*)(kp + 4); }
}
__device__ __forceinline__ unsigned moba_select_regs(const f32x4 (&ks)[8], const bf16x8* qr, int qb, int r32, int hi) {
    f32x16 g = f32x16{}, g2 = f32x16{};
#pragma unroll
    for (int d0 = 0; d0 < 4; ++d0) { f32x4 x0 = ks[2 * d0], x1 = ks[2 * d0 + 1];
        if (r32 >= 8) { x0 = (f32x4){0.f, 0.f, 0.f, 0.f}; x1 = x0; }
        u32x4 wh, wl; f32x4 y0, y1;
        wh.x = cvtpk(x0[0], x0[1]); wh.y = cvtpk(x0[2], x0[3]); wh.z = cvtpk(x1[0], x1[1]); wh.w = cvtpk(x1[2], x1[3]);
        y0[0] = x0[0] - __uint_as_float(wh.x << 16); y0[1] = x0[1] - __uint_as_float(wh.x & 0xffff0000u); y0[2] = x0[2] - __uint_as_float(wh.y << 16); y0[3] = x0[3] - __uint_as_float(wh.y & 0xffff0000u);
        y1[0] = x1[0] - __uint_as_float(wh.z << 16); y1[1] = x1[1] - __uint_as_float(wh.z & 0xffff0000u); y1[2] = x1[2] - __uint_as_float(wh.w << 16); y1[3] = x1[3] - __uint_as_float(wh.w & 0xffff0000u);
        wl.x = cvtpk(y0[0], y0[1]); wl.y = cvtpk(y0[2], y0[3]); wl.z = cvtpk(y1[0], y1[1]); wl.w = cvtpk(y1[2], y1[3]);
        g = __builtin_amdgcn_mfma_f32_32x32x16_bf16(__builtin_bit_cast(bf16x8, wh), qr[d0], g, 0, 0, 0);
        g2 = __builtin_amdgcn_mfma_f32_32x32x16_bf16(__builtin_bit_cast(bf16x8, wl), qr[d0], g2, 0, 0, 0); }
    float G[8];
#pragma unroll
    for (int r = 0; r < 4; ++r) { const float s_ = g[r] + g2[r]; auto rr = __builtin_amdgcn_permlane32_swap(__float_as_uint(s_), __float_as_uint(s_), false, false); G[r] = __uint_as_float(rr[0]); G[4 + r] = __uint_as_float(rr[1]); }
#pragma unroll
    for (int m = 0; m < 8; ++m) G[m] = (m < qb) ? G[m] : -__builtin_inff();
    unsigned selmask = 0u;
#pragma unroll
    for (int n = 0; n < 8; ++n) { int cnt = 0;
#pragma unroll
        for (int m = 0; m < 8; ++m) { if (m < n) cnt += (int)(G[m] >= G[n]); else if (m > n) cnt += (int)(G[m] > G[n]); }
        selmask |= ((unsigned)(cnt < TOPK) & (unsigned)(n < qb)) << n; }
    return selmask;
}
__device__ __forceinline__ unsigned moba_select(const float* ksum, const bf16x8* qr, int qb, int r32, int hi) {
    unsigned selmask = 0u;
        f32x16 g = f32x16{};
#pragma unroll
        for (int d0 = 0; d0 < 4; ++d0) { const float* kp = ksum + (r32 & 7) * 64 + d0 * 16 + hi * 8; f32x4 x0 = *(const f32x4*)kp, x1 = *(const f32x4*)(kp + 4);
            if (r32 >= 8) { x0 = (f32x4){0.f, 0.f, 0.f, 0.f}; x1 = x0; }
            u32x4 wh, wl; f32x4 y0, y1;
            wh.x = cvtpk(x0[0], x0[1]); wh.y = cvtpk(x0[2], x0[3]); wh.z = cvtpk(x1[0], x1[1]); wh.w = cvtpk(x1[2], x1[3]);
            y0[0] = x0[0] - __uint_as_float(wh.x << 16); y0[1] = x0[1] - __uint_as_float(wh.x & 0xffff0000u); y0[2] = x0[2] - __uint_as_float(wh.y << 16); y0[3] = x0[3] - __uint_as_float(wh.y & 0xffff0000u);
            y1[0] = x1[0] - __uint_as_float(wh.z << 16); y1[1] = x1[1] - __uint_as_float(wh.z & 0xffff0000u); y1[2] = x1[2] - __uint_as_float(wh.w << 16); y1[3] = x1[3] - __uint_as_float(wh.w & 0xffff0000u);
            wl.x = cvtpk(y0[0], y0[1]); wl.y = cvtpk(y0[2], y0[3]); wl.z = cvtpk(y1[0], y1[1]); wl.w = cvtpk(y1[2], y1[3]);
            g = __builtin_amdgcn_mfma_f32_32x32x16_bf16(__builtin_bit_cast(bf16x8, wh), qr[d0], g, 0, 0, 0);
            g = __builtin_amdgcn_mfma_f32_32x32x16_bf16(__builtin_bit_cast(bf16x8, wl), qr[d0], g, 0, 0, 0); }
        float G[8];
#pragma unroll
        for (int r = 0; r < 4; ++r) { auto rr = __builtin_amdgcn_permlane32_swap(__float_as_uint(g[r]), __float_as_uint(g[r]), false, false); G[r] = __uint_as_float(rr[0]); G[4 + r] = __uint_as_float(rr[1]); }
#pragma unroll
        for (int n = 0; n < 8; ++n) { int cnt = 0;
#pragma unroll
            for (int m = 0; m < 8; ++m) cnt += (m < qb) && ((G[m] > G[n]) || (G[m] == G[n] && m < n));
            if (n < qb && cnt < TOPK) selmask |= 1u << n; }
    return selmask;
}

__device__ __forceinline__ void load_gate(u32x4* zr, const bf16* Zw, int lane) {
#pragma unroll
    for (int i = 0; i < 4; ++i) zr[i] = RO_NTL ? __builtin_nontemporal_load((const u32x4*)(Zw + (size_t)(i * 8 + (lane >> 3)) * PITCH + (lane & 7) * 8)) : *(const u32x4*)(Zw + (size_t)(i * 8 + (lane >> 3)) * PITCH + (lane & 7) * 8);
}
__device__ __forceinline__ void warm_rows(const bf16* base  , long row0, int ninstr, unsigned dummy_lds, int wid, int lane) {
    const bf16* p = base + (row0 + (long)wid * 8 * ninstr + (lane >> 3)) * PITCH + (lane & 7) * 8;
    for (int i = 0; i < ninstr; ++i) glds16(p + (long)(8 * i) * PITCH, dummy_lds);
}
template <int THRL>
__device__ __forceinline__ void moba_unit(int b, int h, int qb, const bf16* Q, const bf16* __restrict__ K, const bf16* __restrict__ V, const bf16* Z, bf16* O, const float* ksum, const float* relb, LAS char* lds) {
    int tid_ = threadIdx.x; asm volatile("" : "+v"(tid_));
    const int tid = tid_, lane = tid & 63, r32 = lane & 31, hi = lane >> 5; const int wid = __builtin_amdgcn_readfirstlane(tid >> 6);
    const long rowbase = (long)b * SEQ; const int q0 = qb * QB, wq0 = q0 + wid * QBLK;
    const bf16* Qw = Q + (rowbase + wq0) * PITCH + h * HD;
    const bf16* Kh = K + rowbase * PITCH + h * HD; const bf16* Vh = V + rowbase * PITCH + h * HD;
    const unsigned lds0 = (unsigned)(uintptr_t)lds;
    LAS float* wsf = (LAS float*)(lds + LDS_WS) + wid * 64; LAS float* tab = (LAS float*)(lds + LDS_TAB);
    const bf16* ksrc = Kh + (long)lane * PITCH + wid * 8;
    const bf16* vsrc = Vh + (long)(16 * (wid & 3) + (lane >> 2)) * PITCH + (wid >> 2) * 32 + (lane & 3) * 8;
    const unsigned kdst = lds0 + LDS_K + wid * 1024, vdst = lds0 + LDS_V + wid * 1024;
#define DMA_K(t, slot) glds16(ksrc + (long)(t) * KVBLK * PITCH, (unsigned)__builtin_amdgcn_readfirstlane(kdst + (slot)))
#define DMA_V(t, slot) glds16(vsrc + (long)(t) * KVBLK * PITCH, (unsigned)__builtin_amdgcn_readfirstlane(vdst + (slot)))
    const int vb0 = (int)(lds0 + LDS_V) + ((lane >> 4) & 1) * 32 + (lane & 3) * 8 + (4 * hi + ((lane & 15) >> 2)) * 64;
    const lds_cptr Kbase = (lds_cptr)lds + LDS_K;
    if (tid <= 128) tab[tid] = tid < 128 ? (relb[T5B[tid]] - relb[31]) * LOG2E : 0.f;
    DMA_K(0, 0); DMA_V(0, 0);
    bf16x8 qr[4];
#pragma unroll
    for (int d0 = 0; d0 < 4; ++d0) qr[d0] = Q_NTL ? __builtin_nontemporal_load(reinterpret_cast<const bf16x8*>(&Qw[(long)r32 * PITCH + d0 * 16 + hi * 8])) : *reinterpret_cast<const bf16x8*>(&Qw[(long)r32 * PITCH + d0 * 16 + hi * 8]);
    const unsigned selmask = (qb <= TOPK) ? ((1u << qb) - 1u) : moba_select(ksum, qr, qb, r32, hi);
    float mhat = 0.f, l_reg = 0.f; bool set = false; f32x16 o[2]; o[0] = f32x16{}; o[1] = f32x16{};
    const int NT = (q0 + QB) / KVBLK;
    for (int t = 0; t < NT; ++t) {
        const int slot = (t & 1) * SLOTB;
        WAIT_BAR0();
        if (t + 1 < NT) { DMA_K(t + 1, slot ^ SLOTB); DMA_V(t + 1, slot ^ SLOTB); }
        const int key0 = t * KVBLK;
        if (key0 > wq0 + QBLK - 1) continue;
        const int blk = t >> 2; const bool on = (blk == qb) || ((selmask >> blk) & 1u);
        const float nm = on ? -mhat : -1e30f; f32x16 negm;
#pragma unroll
        for (int r = 0; r < 16; ++r) negm[r] = nm;
        f32x16 p0, p1; qkt(p0, p1, Kbase + slot, qr, negm, r32, hi);
        if (wq0 - (key0 + KVBLK - 1) < 128) {
            const int dbase = wq0 + r32 - key0 - 4 * hi;
#pragma unroll
            for (int r = 0; r < 16; ++r) { const int d0_ = dbase - ((r & 3) + 8 * (r >> 2)), d1_ = d0_ - 32;
                const int i0 = d0_ < 0 ? 0 : (d0_ > 128 ? 128 : d0_), i1 = d1_ < 0 ? 0 : (d1_ > 128 ? 128 : d1_);
                p0[r] = d0_ < 0 ? -1e30f : p0[r] + tab[i0]; p1[r] = d1_ < 0 ? -1e30f : p1[r] + tab[i1]; }
        }
        const float rm = rowmax(p0, p1);
        const bool live = rm > -1e29f; const bool need = live && (!set || rm > (float)THRL);
        if (__any(need)) {
            const float dl = live ? (set ? __builtin_fmaxf(rm, 0.f) : rm) : 0.f; const float f = set ? __builtin_amdgcn_exp2f(-dl) : 1.0f;
            mhat += dl; set = set || live; l_reg *= f;
#pragma unroll
            for (int r = 0; r < 16; ++r) { p0[r] -= dl; p1[r] -= dl; }
            if (hi == 0) wsf[r32] = f;
            asm volatile("s_waitcnt lgkmcnt(0)" ::: "memory");
#pragma unroll
            for (int d_ = 0; d_ < 2; ++d_)
#pragma unroll
                for (int r = 0; r < 16; ++r) o[d_][r] *= wsf[crow(r, hi)];
            asm volatile("s_waitcnt lgkmcnt(0)" ::: "memory");
        }
        float sacc = 0.f;
#pragma unroll
        for (int r = 0; r < 16; ++r) { p0[r] = __builtin_amdgcn_exp2f(p0[r]); p1[r] = __builtin_amdgcn_exp2f(p1[r]); sacc += p0[r] + p1[r]; }
        l_reg += sacc;
        u32x4 pw0 = (u32x4){PKW(p0, 0), PKW(p0, 2), PKW(p0, 4), PKW(p0, 6)}, pw1 = (u32x4){PKW(p0, 8), PKW(p0, 10), PKW(p0, 12), PKW(p0, 14)};
        u32x4 pw2 = (u32x4){PKW(p1, 0), PKW(p1, 2), PKW(p1, 4), PKW(p1, 6)}, pw3 = (u32x4){PKW(p1, 8), PKW(p1, 10), PKW(p1, 12), PKW(p1, 14)};
        pv(o, vb0 + slot, __builtin_bit_cast(bf16x8, pw0), __builtin_bit_cast(bf16x8, pw1), __builtin_bit_cast(bf16x8, pw2), __builtin_bit_cast(bf16x8, pw3));
    }
    { auto rr = __builtin_amdgcn_permlane32_swap(__float_as_uint(l_reg), __float_as_uint(l_reg), false, false); l_reg = __uint_as_float(rr[0]) + __uint_as_float(rr[1]); }
    if (hi == 0) wsf[32 + r32] = l_reg; asm volatile("s_waitcnt lgkmcnt(0)" ::: "memory");
    float rli[16];
#pragma unroll
    for (int r = 0; r < 16; ++r) rli[r] = __builtin_amdgcn_rcpf(wsf[32 + crow(r, hi)]);
    { u32x4 zr[4]; load_gate(zr, Z + (rowbase + wq0) * PITCH + h * HD, lane); store_gated(o, rli, lds + LDS_OST + wid * 4096, zr, O + (rowbase + wq0) * OPITCH + h * HD, lane, r32, hi); }
    asm volatile("s_waitcnt vmcnt(0) lgkmcnt(0)\n\ts_barrier" ::: "memory");
#undef DMA_K
#undef DMA_V
}

__device__ __forceinline__ void sb_unit(int b, int h, int qb, const bf16* Q, const bf16* __restrict__ K, const bf16* __restrict__ V, const bf16* Z, bf16* O, LAS char* lds) {
    int tid_ = threadIdx.x; asm volatile("" : "+v"(tid_));
    const int tid = tid_, lane = tid & 63, r32 = lane & 31, hi = lane >> 5; const int wid = __builtin_amdgcn_readfirstlane(tid >> 6);
    const long rowbase = (long)b * SEQ; const int q0 = qb * QB, wq0 = q0 + wid * QBLK;
    const bf16* Qw = Q + (rowbase + wq0) * PITCH + h * HD;
    const bf16* Kh = K + rowbase * PITCH + h * HD; const bf16* Vh = V + rowbase * PITCH + h * HD;
    const unsigned lds0 = (unsigned)(uintptr_t)lds;
    volatile LAS unsigned* flg = (volatile LAS unsigned*)(lds + LDS_FLAG);
    const bf16* ksrc = Kh + (long)lane * PITCH + wid * 8;
    const bf16* vsrc = Vh + (long)(16 * (wid & 3) + (lane >> 2)) * PITCH + (wid >> 2) * 32 + (lane & 3) * 8;
    const unsigned kdst = lds0 + LDS_K + wid * 1024, vdst = lds0 + LDS_V + wid * 1024;
#define DMA_K(t, slot) glds16(ksrc + (long)(t) * KVBLK * PITCH, (unsigned)__builtin_amdgcn_readfirstlane(kdst + (slot)))
#define DMA_V(t, slot) glds16(vsrc + (long)(t) * KVBLK * PITCH, (unsigned)__builtin_amdgcn_readfirstlane(vdst + (slot)))
    const int vb0 = (int)(lds0 + LDS_V) + ((lane >> 4) & 1) * 32 + (lane & 3) * 8 + (4 * hi + ((lane & 15) >> 2)) * 64;
    const lds_cptr Kbase = (lds_cptr)lds + LDS_K;
    const int NT = (q0 + QB) / KVBLK;
    if (tid < 16) flg[tid] = 0u;
    DMA_K(NT - 1, 0); DMA_V(NT - 1, 0);
    bf16x8 qr[4];
#pragma unroll
    for (int d0 = 0; d0 < 4; ++d0) qr[d0] = Q_NTL ? __builtin_nontemporal_load(reinterpret_cast<const bf16x8*>(&Qw[(long)r32 * PITCH + d0 * 16 + hi * 8])) : *reinterpret_cast<const bf16x8*>(&Qw[(long)r32 * PITCH + d0 * 16 + hi * 8]);
    f16x8 tA[2], ones;
#pragma unroll
    for (int s_ = 0; s_ < 2; ++s_)
#pragma unroll
        for (int jj = 0; jj < 8; ++jj) { const int key = 16 * s_ + 8 * (jj >> 2) + 4 * hi + (jj & 3); tA[s_][jj] = (key >= r32) ? (_Float16)1.0f : (_Float16)0.0f; }
#pragma unroll
    for (int jj = 0; jj < 8; ++jj) ones[jj] = (_Float16)1.0f;
    float carry = 0.f; bool done = false; f32x16 o[2]; o[0] = f32x16{}; o[1] = f32x16{};
    const f32x16 zero16 = f32x16{};
    for (int i = 0; i < NT; ++i) {
        const int t = NT - 1 - i, slot = (i & 1) * SLOTB;
        WAIT_BAR0();
        { volatile LAS unsigned* fr_ = flg + ((i & 1) ^ 1) * 8;
          const unsigned a = fr_[0] & fr_[1] & fr_[2] & fr_[3] & fr_[4] & fr_[5] & fr_[6] & fr_[7]; if (a != 0u) break; }
        if (t > 0) { DMA_K(t - 1, slot ^ SLOTB); DMA_V(t - 1, slot ^ SLOTB); }
        const int key0 = t * KVBLK;
        if (!(done || key0 > wq0 + QBLK - 1)) {
        f32x16 z0, z1; qkt(z0, z1, Kbase + slot, qr, zero16, r32, hi);
        const bool band = (key0 + KVBLK - 1 >= wq0);
        const int dbase = wq0 + r32 - key0 - 4 * hi;
        f32x16 l0, l1;
#pragma unroll
        for (int r = 0; r < 16; ++r) { const int d0_ = dbase - ((r & 3) + 8 * (r >> 2)), d1_ = d0_ - 32;
            float a = __builtin_fmaxf(z0[r], 0.f) + __builtin_amdgcn_logf(1.0f + __builtin_amdgcn_exp2f(-__builtin_fabsf(z0[r])));
            float c = __builtin_fmaxf(z1[r], 0.f) + __builtin_amdgcn_logf(1.0f + __builtin_amdgcn_exp2f(-__builtin_fabsf(z1[r])));
            if (band) { a = d0_ > 0 ? a : 0.f; c = d1_ > 0 ? c : 0.f; }
            l0[r] = a; l1[r] = c; }
        u32x4 lf0 = (u32x4){cvtpk_h(l0[0], l0[1]), cvtpk_h(l0[2], l0[3]), cvtpk_h(l0[4], l0[5]), cvtpk_h(l0[6], l0[7])}, lf1 = (u32x4){cvtpk_h(l0[8], l0[9]), cvtpk_h(l0[10], l0[11]), cvtpk_h(l0[12], l0[13]), cvtpk_h(l0[14], l0[15])};
        u32x4 lf2 = (u32x4){cvtpk_h(l1[0], l1[1]), cvtpk_h(l1[2], l1[3]), cvtpk_h(l1[4], l1[5]), cvtpk_h(l1[6], l1[7])}, lf3 = (u32x4){cvtpk_h(l1[8], l1[9]), cvtpk_h(l1[10], l1[11]), cvtpk_h(l1[12], l1[13]), cvtpk_h(l1[14], l1[15])};
        f32x16 ct;
#pragma unroll
        for (int r = 0; r < 16; ++r) ct[r] = carry;
        f32x16 i1 = __builtin_amdgcn_mfma_f32_32x32x16_f16(tA[0], __builtin_bit_cast(f16x8, lf2), ct, 0, 0, 0);
        i1 = __builtin_amdgcn_mfma_f32_32x32x16_f16(tA[1], __builtin_bit_cast(f16x8, lf3), i1, 0, 0, 0);
        f32x16 i0 = __builtin_amdgcn_mfma_f32_32x32x16_f16(ones, __builtin_bit_cast(f16x8, lf2), ct, 0, 0, 0);
        i0 = __builtin_amdgcn_mfma_f32_32x32x16_f16(ones, __builtin_bit_cast(f16x8, lf3), i0, 0, 0, 0);
        i0 = __builtin_amdgcn_mfma_f32_32x32x16_f16(tA[0], __builtin_bit_cast(f16x8, lf0), i0, 0, 0, 0);
        i0 = __builtin_amdgcn_mfma_f32_32x32x16_f16(tA[1], __builtin_bit_cast(f16x8, lf1), i0, 0, 0, 0);
#pragma unroll
        for (int r = 0; r < 16; ++r) { const int d0_ = dbase - ((r & 3) + 8 * (r >> 2)), d1_ = d0_ - 32;
            float a = __builtin_amdgcn_exp2f(z0[r] - i0[r]), c = __builtin_amdgcn_exp2f(z1[r] - i1[r]);
            if (band) { a = d0_ > 0 ? a : 0.f; c = d1_ > 0 ? c : 0.f; }
            z0[r] = a; z1[r] = c; }
        carry = lowhalf(i0[0]);
        u32x4 pw0 = (u32x4){PKW(z0, 0), PKW(z0, 2), PKW(z0, 4), PKW(z0, 6)}, pw1 = (u32x4){PKW(z0, 8), PKW(z0, 10), PKW(z0, 12), PKW(z0, 14)};
        u32x4 pw2 = (u32x4){PKW(z1, 0), PKW(z1, 2), PKW(z1, 4), PKW(z1, 6)}, pw3 = (u32x4){PKW(z1, 8), PKW(z1, 10), PKW(z1, 12), PKW(z1, 14)};
        pv(o, vb0 + slot, __builtin_bit_cast(bf16x8, pw0), __builtin_bit_cast(bf16x8, pw1), __builtin_bit_cast(bf16x8, pw2), __builtin_bit_cast(bf16x8, pw3));
        if (__all(carry >= SB_EXIT)) done = true;
        }
        if (lane == 0) flg[(i & 1) * 8 + wid] = done ? 1u : 0u;
    }
    { long ro_ = rowbase + wq0; asm volatile("" : "+s"(ro_)); u32x4 zr[4]; load_gate(zr, Z + ro_ * PITCH + h * HD, lane); store_gated(o, nullptr, lds + LDS_OST + wid * 4096, zr, O + ro_ * OPITCH + h * HD, lane, r32, hi); }
    asm volatile("s_waitcnt vmcnt(0) lgkmcnt(0)\n\ts_barrier" ::: "memory");
#undef DMA_K
#undef DMA_V
}

__device__ __forceinline__ void sb_unit_w(int b, int h, int qb, const bf16* Q, const bf16* __restrict__ K, const bf16* __restrict__ V, const bf16* Z, bf16* O, LAS char* lds, unsigned* ordy  , const bool pre  , const unsigned nxtd  ) {
    int tid_ = threadIdx.x; asm volatile("" : "+v"(tid_));
    const int tid = tid_, lane = tid & 63, r32 = lane & 31, hi = lane >> 5; const int wid = __builtin_amdgcn_readfirstlane(tid >> 6);
    const long rowbase = (long)b * SEQ; const int wq0 = qb * QB + wid * QBLK;
    const bf16* Qw = Q + (rowbase + wq0) * PITCH + h * HD;
    const bf16* Kh = K + rowbase * PITCH + h * HD; const bf16* Vh = V + rowbase * PITCH + h * HD;
    LAS char* wl = lds + wid * 16384;
    const unsigned lds0 = (unsigned)(uintptr_t)wl;
    const bf16* ksrc = Kh + (long)(lane & 31) * PITCH + (lane >> 5) * 8;
    const bf16* vsrc = Vh + (long)(lane >> 2) * PITCH + (lane & 3) * 8;
#define DMA_T(key0, bf) do { const unsigned d_ = (unsigned)__builtin_amdgcn_readfirstlane(lds0 + (bf) * 8192); const bf16* k_ = ksrc + (long)(key0) * PITCH; const bf16* v_ = vsrc + (long)(key0) * PITCH; \
        _Pragma("unroll") for (int i_ = 0; i_ < 4; ++i_) glds16(k_ + i_ * 16, d_ + i_ * 1024); \
        _Pragma("unroll") for (int i_ = 0; i_ < 4; ++i_) glds16(v_ + (long)((i_ & 1) * 16) * PITCH + (i_ >> 1) * 32, d_ + 4096 + i_ * 1024); } while (0)
    SBT(0);
    const int kt0 = wq0 >> 5;
    const int bf0 = pre ? 1 : 0;
    bf16x8 qr[4];
    if (pre) {
        asm volatile("s_waitcnt vmcnt(0)" ::: "memory");
#pragma unroll
        for (int d0 = 0; d0 < 4; ++d0) qr[d0] = *(const LAS bf16x8*)((lds_cptr)wl + 4096 + r32 * 128 + d0 * 32 + hi * 16);
        asm volatile("s_waitcnt lgkmcnt(0)" ::: "memory");
    } else {
        DMA_T(kt0 * 32, 0);
#pragma unroll
        for (int d0 = 0; d0 < 4; ++d0) qr[d0] = RO_NTL ? __builtin_nontemporal_load(reinterpret_cast<const bf16x8*>(&Qw[(long)r32 * PITCH + d0 * 16 + hi * 8])) : *reinterpret_cast<const bf16x8*>(&Qw[(long)r32 * PITCH + d0 * 16 + hi * 8]);
    }
    u32x4 zr[4]; load_gate(zr, Z + (rowbase + wq0) * PITCH + h * HD, lane);
    f16x8 tA[2];
#pragma unroll
    for (int s_ = 0; s_ < 2; ++s_)
#pragma unroll
        for (int jj = 0; jj < 8; ++jj) { const int key = 16 * s_ + 8 * (jj >> 2) + 4 * hi + (jj & 3); tA[s_][jj] = (key >= r32) ? (_Float16)1.0f : (_Float16)0.0f; }
    float carry = 0.f; f32x16 o[2]; o[0] = f32x16{}; o[1] = f32x16{};
    const int vbl = (int)lds0 + 4096 + ((lane >> 4) & 1) * 32 + (lane & 3) * 8 + (4 * hi + ((lane & 15) >> 2)) * 64;
    asm volatile("" : "+v"(qr[0]), "+v"(qr[1]), "+v"(qr[2]), "+v"(qr[3]));
    if (SBPRIO && wid >= 4) __builtin_amdgcn_s_setprio(1);
#pragma unroll 1
    for (int i = 0;; ++i) { const int kt = kt0 - i, bf = (i + bf0) & 1;
        if (kt > 0) { DMA_T((kt - 1) * 32, bf ^ 1); if (pre && i == 0) asm volatile("s_waitcnt vmcnt(12)" ::: "memory"); else asm volatile("s_waitcnt vmcnt(8)" ::: "memory"); }
        else if (!(pre && i == 0)) asm volatile("s_waitcnt vmcnt(0)" ::: "memory");
        if (i == 0) SBT(1);
        const lds_cptr kb = (lds_cptr)wl + bf * 8192 + hi * 512 + r32 * 16;
        f32x16 z = f32x16{};
#pragma unroll
        for (int d0 = 0; d0 < 4; ++d0) { const bf16x8 a = *(const LAS bf16x8*)(kb + d0 * 1024); z = __builtin_amdgcn_mfma_f32_32x32x16_bf16(a, qr[d0], z, 0, 0, 0); }
        const bool band = (i == 0);
        f32x16 l;
#pragma unroll
        for (int r = 0; r < 16; ++r) { float a = __builtin_fmaxf(z[r], 0.f) + __builtin_amdgcn_logf(1.0f + __builtin_amdgcn_exp2f(-__builtin_fabsf(z[r])));
            if (band) a = (((r & 3) + 8 * (r >> 2) + 4 * hi) < r32) ? a : 0.f;
            l[r] = a; }
        const u32x4 lf0 = (u32x4){cvtpk_h(l[0], l[1]), cvtpk_h(l[2], l[3]), cvtpk_h(l[4], l[5]), cvtpk_h(l[6], l[7])}, lf1 = (u32x4){cvtpk_h(l[8], l[9]), cvtpk_h(l[10], l[11]), cvtpk_h(l[12], l[13]), cvtpk_h(l[14], l[15])};
        f32x16 ct;
#pragma unroll
        for (int r = 0; r < 16; ++r) ct[r] = carry;
        f32x16 ii = __builtin_amdgcn_mfma_f32_32x32x16_f16(tA[0], __builtin_bit_cast(f16x8, lf0), ct, 0, 0, 0);
        ii = __builtin_amdgcn_mfma_f32_32x32x16_f16(tA[1], __builtin_bit_cast(f16x8, lf1), ii, 0, 0, 0);
#pragma unroll
        for (int r = 0; r < 16; ++r) { float a = __builtin_amdgcn_exp2f(z[r] - ii[r]); if (band) a = (((r & 3) + 8 * (r >> 2) + 4 * hi) < r32) ? a : 0.f; z[r] = a; }
        carry = lowhalf(ii[0]);
        const u32x4 pw0 = (u32x4){cvtpk(z[0], z[1]), cvtpk(z[2], z[3]), cvtpk(z[4], z[5]), cvtpk(z[6], z[7])}, pw1 = (u32x4){cvtpk(z[8], z[9]), cvtpk(z[10], z[11]), cvtpk(z[12], z[13]), cvtpk(z[14], z[15])};
        { const int vb = vbl + bf * 8192;
#pragma unroll
          for (int d0 = 0; d0 < 2; ++d0) { s16x4 lo[2], hh[2];
#pragma unroll
            for (int ks = 0; ks < 2; ++ks) {
                asm volatile("ds_read_b64_tr_b16 %0,%1 offset:%c2" : "=&v"(lo[ks]) : "v"(vb), "i"(d0 * 2048 + ks * 1024) : "memory");
                asm volatile("ds_read_b64_tr_b16 %0,%1 offset:%c2" : "=&v"(hh[ks]) : "v"(vb), "i"(d0 * 2048 + ks * 1024 + 512) : "memory"); }
            asm volatile("s_waitcnt lgkmcnt(0)" ::: "memory"); __builtin_amdgcn_sched_barrier(0);
            o[d0] = __builtin_amdgcn_mfma_f32_32x32x16_bf16(__builtin_bit_cast(bf16x8, pw0), (bf16x8){lo[0][0], lo[0][1], lo[0][2], lo[0][3], hh[0][0], hh[0][1], hh[0][2], hh[0][3]}, o[d0], 0, 0, 0);
            o[d0] = __builtin_amdgcn_mfma_f32_32x32x16_bf16(__builtin_bit_cast(bf16x8, pw1), (bf16x8){lo[1][0], lo[1][1], lo[1][2], lo[1][3], hh[1][0], hh[1][1], hh[1][2], hh[1][3]}, o[d0], 0, 0, 0); } }
        if (kt == 0 || __all(carry >= SB_EXIT)) break;
    }
    SBT(2);
    asm volatile("s_waitcnt vmcnt(0) lgkmcnt(0)" ::: "memory");
    { long ro_ = rowbase + wq0; asm volatile("" : "+s"(ro_)); store_gated(o, nullptr, wl, zr, O + (ro_ >> 8) * (long)OPAN + (ro_ & 255) * OPITCH + h * HD, lane, r32, hi); }
    const int ncls = (int)((nxtd & 255u) >> 4); const bool chain = (nxtd != 0xffffffffu) && (QORDER ? (ncls >= 8) : ((ncls >= 6 && ncls <= 12) || ncls == 14));
    if (chain) { const int nbh = 16 * (int)(nxtd >> 8) + (int)(nxtd & 15u), nb = nbh >> 3, nh = nbh & 7, nqb = QORDER ? (7 - (ncls & 7)) : ((ncls <= 12) ? 13 - ncls : 0);
        const long nrb = (long)nb * SEQ; const int nwq0 = nqb * QB + wid * QBLK;
        const bf16* k_ = K + nrb * PITCH + nh * HD + (long)(lane & 31) * PITCH + (lane >> 5) * 8 + (long)nwq0 * PITCH; const bf16* v_ = V + nrb * PITCH + nh * HD + (long)(lane >> 2) * PITCH + (lane & 3) * 8 + (long)nwq0 * PITCH;
        const unsigned d_ = (unsigned)__builtin_amdgcn_readfirstlane(lds0 + 8192);
#pragma unroll
        for (int i_ = 0; i_ < 4; ++i_) glds16(k_ + i_ * 16, d_ + i_ * 1024);
#pragma unroll
        for (int i_ = 0; i_ < 4; ++i_) glds16(v_ + (long)((i_ & 1) * 16) * PITCH + (i_ >> 1) * 32, d_ + 4096 + i_ * 1024);
        const bf16* q_ = Q + (nrb + nwq0 + (lane >> 3)) * PITCH + nh * HD + (lane & 7) * 8; const unsigned qd_ = (unsigned)__builtin_amdgcn_readfirstlane(lds0 + 4096);
#pragma unroll
        for (int i_ = 0; i_ < 4; ++i_) glds16(q_ + (long)(8 * i_) * PITCH, qd_ + i_ * 1024);
    }
    if (ordy) { if (chain) asm volatile("s_waitcnt vmcnt(12)" ::: "memory"); else asm volatile("s_waitcnt vmcnt(0)" ::: "memory");
        if (lane == 0) (void)__hip_atomic_fetch_add(ordy, 1u, __ATOMIC_RELAXED, __HIP_MEMORY_SCOPE_AGENT); }
    SBT(3);
    if (SBPRIO && wid >= 4) __builtin_amdgcn_s_setprio(0);
    asm volatile("s_waitcnt lgkmcnt(0)\n\ts_barrier" ::: "memory");
    SBT(4);
#undef DMA_T
}
#undef PKW
#undef MX3
#define WAIT_BAR(N) asm volatile("s_waitcnt vmcnt(" #N ") lgkmcnt(0)\n\ts_barrier":::"memory")
template<int THRL> __device__ __forceinline__ void moba_unit_t(int b,int h,int qb,const bf16*Q,const bf16*__restrict__ K,const bf16*__restrict__ V,const bf16*Z,bf16*O,const float*ksum,const LAS float*tab,LAS char*shm,unsigned*ordy,const bool pre  ,bf16x8(&qc)[4],const int s0  ,const unsigned nxtd  ,int&s0n){
  int tid_=threadIdx.x; asm volatile("":"+v"(tid_));
  const int tid=tid_,lane=tid&63,r32=lane&31,hi=lane>>5; const int wid=__builtin_amdgcn_readfirstlane(tid>>6);
  const long rowbase=(long)b*SEQ; const int q0=qb*QB, wq0=q0+wid*QBLK;
  const bf16*Qw=Q+(rowbase+q0+wid*QBLK)*PITCH+h*HD;
  const bf16*Kh=K+rowbase*PITCH+h*HD,*Vh=V+rowbase*PITCH+h*HD;
  const unsigned lds0=(unsigned)(uintptr_t)shm;
  LAS float*wsf=(LAS float*)(shm+LDS_WS)+wid*64;
  const bf16*ksrc=Kh+(long)lane*PITCH+wid*8;
  const bf16*vsrc=Vh+(long)(16*(wid&3)+(lane>>2))*PITCH+(wid>>2)*32+(lane&3)*8;
  const unsigned kdst=lds0+LDS_K+wid*1024, vdst=lds0+LDS_V+wid*1024;
  #define DMA_K(t,slot) glds16(ksrc+(long)(t)*KVBLK*PITCH,(unsigned)__builtin_amdgcn_readfirstlane(kdst+(slot)))
  #define DMA_V(t,slot) glds16(vsrc+(long)(t)*KVBLK*PITCH,(unsigned)__builtin_amdgcn_readfirstlane(vdst+(slot)))
  const int vb0=(int)(lds0+LDS_V)+((lane>>4)&1)*32+(lane&3)*8+(4*hi+((lane&15)>>2))*64;
  const lds_cptr Kbase=(lds_cptr)shm+LDS_K; bf16x8 kf[8];
  const lds_cptr shm3=(lds_cptr)shm; const lds_cptr kp0=shm3+LDS_K+hi*1024+r32*16; const lds_cptr vp0=shm3+LDS_V+((lane>>4)&1)*32+(lane&3)*8+(4*hi+((lane&15)>>2))*64;
  const int NT=(q0+QB)/KVBLK;
  UTS(0);
#ifdef UT_PROBE
#endif
  const int sA=s0,sB=(sA==(NSLOT-1)*SLOTB)?0:sA+SLOTB,sC=(sB==(NSLOT-1)*SLOTB)?0:sB+SLOTB;
  bf16x8 qr[4];
  f32x4 ksv[8];
  if(pre){
    asm volatile("s_waitcnt vmcnt(0)\n\ts_barrier":::"memory");
    #pragma unroll
    for(int d0=0;d0<4;++d0)qr[d0]=qc[d0];
    if(qb>TOPK){ if(r32<8){ const lds_cptr kl_=(lds_cptr)shm+LDS_KSN+(r32&7)*256+hi*32; _Pragma("unroll") for(int d0=0;d0<4;++d0){ ksv[2*d0]=*(const LAS f32x4*)(kl_+d0*64); ksv[2*d0+1]=*(const LAS f32x4*)(kl_+d0*64+16); } }
      else{ _Pragma("unroll") for(int i=0;i<8;++i)ksv[i]=(f32x4){0.f,0.f,0.f,0.f}; } }
  }else{
    #pragma unroll
    for(int d0=0;d0<4;++d0)qr[d0]=RO_NTL?__builtin_nontemporal_load(reinterpret_cast<const bf16x8*>(&Qw[(long)r32*PITCH+d0*16+hi*8])):*reinterpret_cast<const bf16x8*>(&Qw[(long)r32*PITCH+d0*16+hi*8]);
    if(qb>TOPK){ if(r32<8)moba_ksum_load(ksv,ksum,r32,hi); else{ _Pragma("unroll") for(int i=0;i<8;++i)ksv[i]=(f32x4){0.f,0.f,0.f,0.f}; } }
    asm volatile("":::"memory");
    DMA_K(0,sA);DMA_V(0,sA);
  }
  unsigned selmask=(qb<=TOPK)?((1u<<qb)-1u):0u;
  UTS(6); if(qb>TOPK)selmask=moba_select_regs(ksv,qr,qb,r32,hi); asm volatile(""::"v"(selmask)); UTS(5);
  bool on=(qb==0)||(selmask&1u);
  float mhat=0.f,l_reg=0.f;f32x16 o[2];o[0]=f32x16{};o[1]=f32x16{};f32x16 negm;
  { const float nm_=on?0.f:-1e30f; _Pragma("unroll") for(int r=0;r<16;++r)negm[r]=nm_; } asm volatile("":"+v"(negm));
  #define NEARMASK(P0,P1,tt) do{ const int key0_=(tt)*KVBLK; \
    if(key0_>wq0+QBLK-1){ _Pragma("unroll") for(int r=0;r<16;++r){P0[r]=-1e30f;P1[r]=-1e30f;} }     \
    else if(wq0-(key0_+KVBLK-1)<128){ const int dbase_=wq0+r32-key0_-4*hi+1; \
      _Pragma("unroll") for(int r=0;r<16;++r){ const int d0_=dbase_-((r&3)+8*(r>>2)),d1_=d0_-32; const int i0_=d0_<0?0:(d0_>129?129:d0_),i1_=d1_<0?0:(d1_>129?129:d1_); \
        P0[r]+=tab[i0_]; P1[r]+=tab[i1_]; if((r&3)==3){ asm volatile("":"+v"(P0),"+v"(P1)); SBAR(); } } } }while(0)
  #define CMASK(P0,P1,t) NEARMASK(P0,P1,t)
  #define BLKUPD(tile) do{ if((((tile))&3)==0){ const int blk_=(tile)>>2; on=(blk_==qb)||((selmask>>blk_)&1u); const float nm_=on?-mhat:-1e30f; \
      _Pragma("unroll") for(int r=0;r<16;++r)negm[r]=nm_; asm volatile("":"+v"(negm)); } }while(0)
  bool resc=false;
  #define START(P0,P1) do{ const float rm=rowmax(P0,P1); resc=false; \
    { const float dl=(rm>-1e29f)?rm:0.f; mhat=fadd_s(mhat,dl); \
      _Pragma("unroll") for(int r=0;r<16;++r){P0[r]=fsub_s(P0[r],dl);P1[r]=fsub_s(P1[r],dl);} \
      { const float nm_=on?-mhat:-1e30f; _Pragma("unroll") for(int r=0;r<16;++r)negm[r]=nm_; } asm volatile("":"+v"(negm)); } \
    _Pragma("unroll") for(int r=0;r<16;++r)P0[r]=__builtin_amdgcn_exp2f(P0[r]); }while(0)
  #define RESC() do{ if(resc){ asm volatile("s_waitcnt lgkmcnt(0)":::"memory"); \
      _Pragma("unroll") for(int d_=0;d_<2;++d_) _Pragma("unroll") for(int r=0;r<16;++r)o[d_][r]*=wsf[crow(r,hi)]; } }while(0)
  f32x16 pA0,pA1,pB0,pB1;
  int sl_prev=sA,sl_cur=sA,sl_next=sB;
  #define ROT() do{sl_prev=sl_cur;sl_cur=sl_next;sl_next=(sl_next==(NSLOT-1)*SLOTB)?0:sl_next+SLOTB;}while(0)
  if(!pre){ DMA_K(1,sB);DMA_K(2,sC);
  WAIT_BAR(3); }
  UTS(1);
  qkt(pA0,pA1,Kbase+sA,qr,negm,r32,hi);asm volatile("s_nop 15\n\ts_nop 7":"+v"(pA0),"+v"(pA1));CMASK(pA0,pA1,0);
  START(pA0,pA1);
  _Pragma("unroll") for(int r=0;r<16;++r)pA1[r]=__builtin_amdgcn_exp2f(pA1[r]);
  WAIT_BAR(0);
  DMA_K(3,sA);DMA_V(1,sB);
  { const bf16*zs_=Z+(rowbase+wq0+(lane>>3))*PITCH+h*HD+(lane&7)*8; const unsigned zd_=(unsigned)__builtin_amdgcn_readfirstlane(lds0+LDS_ZST+wid*4096);
    _Pragma("unroll") for(int i=0;i<4;++i)glds16(zs_+(long)(8*i)*PITCH,zd_+i*1024); }
  ROT();
  kload8(kf,kp0+sl_cur);
  WAIT_BAR(6);
  s16x4 vlo[8],vhi[8]; u32x4 pw0,pw1,pw2,pw3;
  #define PKW(P,B) cvtpk_s(P[B],P[B+1])
  #define PAF(k) __builtin_bit_cast(bf16x8,pw##k)
  #define VFR(i) (bf16x8){vlo[i][0],vlo[i][1],vlo[i][2],vlo[i][3],vhi[i][0],vhi[i][1],vhi[i][2],vhi[i][3]}
  #define PIN(x) asm volatile("":"+v"(x))
  #define MX3(a,b,c) __builtin_fmaxf(__builtin_fmaxf((a),(b)),(c))
  #define GAPA(MF,A0,A1,A2,A3,W0,W1,PW) do{ MF; sacc+=A0; sacc+=A1; sacc+=A2; sacc+=A3; PIN(sacc); W0; W1; PIN(PW); SBAR(); }while(0)
  #define EX(v) __builtin_amdgcn_exp2f(v)
  #define GAPB(MF,X,B) do{ MF; X[B]=EX(X[B]); X[B+1]=EX(X[B+1]); X[B+2]=EX(X[B+2]); X[B+3]=EX(X[B+3]); PIN(X); SBAR(); }while(0)
  #define VRD(i) do{ vlo[i]=vtr(vp_+(((i)>>2)*4096+((i)&3)*1024)); vhi[i]=vtr(vp_+(((i)>>2)*4096+((i)&3)*1024+512)); }while(0)
  #define KRD(G,j) do{ if(G){ kload2(kf,kp0+sl_next,j); SBAR(); } }while(0)
  #define STEP(C0,C1,P0,P1,t,GK,GV,GL) do{ SBAR(); \
    const lds_cptr vp_=vp0+sl_prev; \
    VRD(0); SBAR(); float sacc=(P0[0]+P0[1]); \
    GAPA(C0=__builtin_amdgcn_mfma_f32_32x32x16_bf16(kf[0],qr[0],negm,0,0,0), P0[2],P0[3],P0[4],P0[5],     pw0[0]=PKW(P0,0), pw0[1]=PKW(P0,2), pw0); \
    VRD(4); SBAR(); GAPA(C1=__builtin_amdgcn_mfma_f32_32x32x16_bf16(kf[1],qr[0],negm,0,0,0), P0[6],P0[7],P0[8],P0[9],     pw0[2]=PKW(P0,4), pw0[3]=PKW(P0,6), pw0); \
    VRD(1); SBAR(); GAPA(C0=__builtin_amdgcn_mfma_f32_32x32x16_bf16(kf[2],qr[1],C0,0,0,0),   P0[10],P0[11],P0[12],P0[13], pw1[0]=PKW(P0,8), pw1[1]=PKW(P0,10), pw1); \
    VRD(5); SBAR(); GAPA(C1=__builtin_amdgcn_mfma_f32_32x32x16_bf16(kf[3],qr[1],C1,0,0,0),   P0[14],P0[15],P1[0],P1[1],   pw1[2]=PKW(P0,12),pw1[3]=PKW(P0,14), pw1); \
    VRD(2); SBAR(); GAPA(C0=__builtin_amdgcn_mfma_f32_32x32x16_bf16(kf[4],qr[2],C0,0,0,0),   P1[2],P1[3],P1[4],P1[5],     pw2[0]=PKW(P1,0), pw2[1]=PKW(P1,2), pw2); \
    VRD(6); SBAR(); GAPA(C1=__builtin_amdgcn_mfma_f32_32x32x16_bf16(kf[5],qr[2],C1,0,0,0),   P1[6],P1[7],P1[8],P1[9],     pw2[2]=PKW(P1,4), pw2[3]=PKW(P1,6), pw2); \
    VRD(3); SBAR(); GAPA(C0=__builtin_amdgcn_mfma_f32_32x32x16_bf16(kf[6],qr[3],C0,0,0,0),   P1[10],P1[11],P1[12],P1[13], pw3[0]=PKW(P1,8), pw3[1]=PKW(P1,10), pw3); \
    VRD(7); SBAR(); GAPA(C1=__builtin_amdgcn_mfma_f32_32x32x16_bf16(kf[7],qr[3],C1,0,0,0),   P1[14],P1[15],0.f,0.f,       pw3[2]=PKW(P1,12),pw3[3]=PKW(P1,14), pw3); \
    l_reg+=sacc; \
    if(GK){DMA_K((t)+3,sl_cur);} if(GV){DMA_V((t)+1,sl_next);} \
    CMASK(C0,C1,t); \
    { float a=MX3(C0[0],C0[1],C1[0]),b=MX3(C0[2],C0[3],C1[1]); a=MX3(a,C1[2],C1[3]); \
      _Pragma("unroll") for(int r=4;r<16;r+=4){a=MX3(a,C0[r],C0[r+1]);b=MX3(b,C0[r+2],C0[r+3]);a=MX3(a,C1[r],C1[r+1]);b=MX3(b,C1[r+2],C1[r+3]);} \
      float rm=__builtin_fmaxf(a,b); { auto rr=__builtin_amdgcn_permlane32_swap(__float_as_uint(rm),__float_as_uint(rm),false,false); rm=__builtin_fmaxf(__uint_as_float(rr[0]),__uint_as_float(rr[1])); } \
      resc=false; \
      if(__builtin_expect(__any(rm>(float)THRL),0)){ const float dl=__builtin_fmaxf(rm,0.f); mhat+=dl; \
        _Pragma("unroll") for(int r=0;r<16;++r){C0[r]-=dl;C1[r]-=dl;} \
        { const float nm_=on?-mhat:-1e30f; _Pragma("unroll") for(int r=0;r<16;++r)negm[r]=nm_; } asm volatile("":"+v"(negm)); \
        const float f=__builtin_amdgcn_exp2f(-dl); l_reg*=f; if(hi==0)wsf[r32]=f; resc=true; } } \
    SBAR(); \
    GAPB(o[0]=__builtin_amdgcn_mfma_f32_32x32x16_bf16(PAF(0),VFR(0),o[0],0,0,0), C0,0); \
    GAPB(o[1]=__builtin_amdgcn_mfma_f32_32x32x16_bf16(PAF(0),VFR(4),o[1],0,0,0), C0,4); \
    KRD(GL,0); GAPB(o[0]=__builtin_amdgcn_mfma_f32_32x32x16_bf16(PAF(1),VFR(1),o[0],0,0,0), C0,8); \
    KRD(GL,1); GAPB(o[1]=__builtin_amdgcn_mfma_f32_32x32x16_bf16(PAF(1),VFR(5),o[1],0,0,0), C0,12); \
    KRD(GL,2); GAPB(o[0]=__builtin_amdgcn_mfma_f32_32x32x16_bf16(PAF(2),VFR(2),o[0],0,0,0), C1,0); \
    KRD(GL,3); GAPB(o[1]=__builtin_amdgcn_mfma_f32_32x32x16_bf16(PAF(2),VFR(6),o[1],0,0,0), C1,4); \
    GAPB(o[0]=__builtin_amdgcn_mfma_f32_32x32x16_bf16(PAF(3),VFR(3),o[0],0,0,0), C1,8); \
    GAPB(o[1]=__builtin_amdgcn_mfma_f32_32x32x16_bf16(PAF(3),VFR(7),o[1],0,0,0), C1,12); \
    }while(0)
  if(YPRIO&&wid>=4)__builtin_amdgcn_s_setprio(1);
  int t=1;
  UTS(2);
  #undef CMASK
  #define CMASK(P0,P1,t) do{}while(0)
  for(;t+9<NT;t+=2){
    BLKUPD(t);   STEP(pB0,pB1,pA0,pA1,t,true,true,true);     WAIT_BAR(2); RESC(); ROT();
    BLKUPD(t+1); STEP(pA0,pA1,pB0,pB1,t+1,true,true,true);   WAIT_BAR(2); RESC(); ROT();
  }
  #undef CMASK
  #define CMASK(P0,P1,t) NEARMASK(P0,P1,t)
  #define ENDW(tt) do{ if((tt)+3<NT){WAIT_BAR(2);} else if((tt)+2<NT){WAIT_BAR(1);} else {WAIT_BAR(0);} }while(0)
  for(;t+1<NT;t+=2){
    BLKUPD(t);   STEP(pB0,pB1,pA0,pA1,t,(t+3<NT),(t+1<NT),(t+1<NT));       ENDW(t);   RESC(); ROT();
    BLKUPD(t+1); STEP(pA0,pA1,pB0,pB1,t+1,(t+4<NT),(t+2<NT),(t+2<NT));     ENDW(t+1); RESC(); ROT();
  }
  const int ncls_=(int)((nxtd&255u)>>4); const bool chain=(nxtd!=0xffffffffu)&&!(QORDER?(ncls_>=8):((ncls_>=6&&ncls_<=12)||ncls_==14));
  const int nbh_=16*(int)(nxtd>>8)+(int)(nxtd&15u),nb_=nbh_>>3,nh_=nbh_&7,nqb_=QORDER?(7-(ncls_&7)):((ncls_<6)?7-ncls_:(ncls_==13)?1:0);
  if(chain){ const int n0=sl_next,n1=(n0==(NSLOT-1)*SLOTB)?0:n0+SLOTB,n2=(n1==(NSLOT-1)*SLOTB)?0:n1+SLOTB;
    const bf16*nk_=K+((long)nb_*SEQ+lane)*PITCH+nh_*HD+wid*8; const bf16*nv_=V+((long)nb_*SEQ+16*(wid&3)+(lane>>2))*PITCH+nh_*HD+(wid>>2)*32+(lane&3)*8;
    glds16(nk_,(unsigned)__builtin_amdgcn_readfirstlane(kdst+n0)); glds16(nv_,(unsigned)__builtin_amdgcn_readfirstlane(vdst+n0));
    glds16(nk_+(long)KVBLK*PITCH,(unsigned)__builtin_amdgcn_readfirstlane(kdst+n1)); glds16(nk_+2L*KVBLK*PITCH,(unsigned)__builtin_amdgcn_readfirstlane(kdst+n2));
    if(nqb_>TOPK&&wid<2)glds16((const bf16*)(ksum+(long)((nb_*8+nh_)-(b*8+h))*NBLK*64)+(wid*64+lane)*8,(unsigned)__builtin_amdgcn_readfirstlane(lds0+LDS_KSN+wid*1024));
    s0n=n0; }
  BLKUPD(NT-1); STEP(pB0,pB1,pA0,pA1,NT-1,false,false,false); RESC();
  if(chain){ const bf16*Qn_=Q+((long)nb_*SEQ+nqb_*QB+wid*QBLK)*PITCH+nh_*HD;
    _Pragma("unroll") for(int d0=0;d0<4;++d0)qc[d0]=RO_NTL?__builtin_nontemporal_load(reinterpret_cast<const bf16x8*>(&Qn_[(long)r32*PITCH+d0*16+hi*8])):*reinterpret_cast<const bf16x8*>(&Qn_[(long)r32*PITCH+d0*16+hi*8]); }
  else{ _Pragma("unroll") for(int d0=0;d0<4;++d0)qc[d0]=qr[d0]; }
  { float sacc=pB0[0]+pB0[1]; _Pragma("unroll") for(int r=2;r<16;++r)sacc+=pB0[r]; _Pragma("unroll") for(int r=0;r<16;++r)sacc+=pB1[r]; l_reg+=sacc;
    pw0=(u32x4){PKW(pB0,0),PKW(pB0,2),PKW(pB0,4),PKW(pB0,6)};pw1=(u32x4){PKW(pB0,8),PKW(pB0,10),PKW(pB0,12),PKW(pB0,14)};pw2=(u32x4){PKW(pB1,0),PKW(pB1,2),PKW(pB1,4),PKW(pB1,6)};pw3=(u32x4){PKW(pB1,8),PKW(pB1,10),PKW(pB1,12),PKW(pB1,14)};
    SBAR(); pv(o,vb0+sl_cur,PAF(0),PAF(1),PAF(2),PAF(3)); }
  #undef PKW
  #undef PAF
  #undef VFR
  #undef PIN
  #undef MX3
  #undef GAPA
  #undef GAPB
  #undef EX
  #undef VRD
  #undef KRD
  #undef STEP
  #undef ENDW
  UTS(3);
  {auto rr=__builtin_amdgcn_permlane32_swap(__float_as_uint(l_reg),__float_as_uint(l_reg),false,false);l_reg=__uint_as_float(rr[0])+__uint_as_float(rr[1]);}
  if(hi==0)wsf[32+r32]=l_reg;asm volatile("s_waitcnt lgkmcnt(0)":::"memory");
  float rli[16];
  #pragma unroll
  for(int r=0;r<16;++r)rli[r]=__builtin_amdgcn_rcpf(wsf[32+crow(r,hi)]);
  { long ro_=rowbase+wq0; asm volatile("":"+s"(ro_)); u32x4 zr[4]; _Pragma("unroll") for(int i=0;i<4;++i)zr[i]=*(const LAS u32x4*)(shm+LDS_ZST+wid*4096+i*1024+lane*16); store_gated(o,rli,shm+LDS_OST+wid*4096,zr,O+(ro_>>8)*(long)OPAN+(ro_&255)*OPITCH+h*HD,lane,r32,hi); }
  if(ordy){ asm volatile("s_waitcnt vmcnt(0)":::"memory"); if(lane==0)(void)__hip_atomic_fetch_add(ordy,1u,__ATOMIC_RELAXED,__HIP_MEMORY_SCOPE_AGENT); }
  if(YPRIO&&wid>=4)__builtin_amdgcn_s_setprio(0);
  asm volatile("s_waitcnt lgkmcnt(0)\n\ts_barrier":::"memory");
  UTS(4);
  #undef DMA_K
  #undef DMA_V
  #undef CMASK
  #undef NEARMASK
  #undef BLKUPD
  #undef START
  #undef RESC
  #undef ROT
}
#undef WAIT_BAR
#undef SBAR
#undef WAIT_BAR0
}

typedef unsigned short bf16;
typedef unsigned v4u __attribute__((ext_vector_type(4)));
typedef float f32x4 __attribute__((ext_vector_type(4)));
typedef short bf16x8 __attribute__((ext_vector_type(8)));
typedef GAS unsigned gu32;
typedef GAS unsigned long long gu64;
#define RLX_AGENT __ATOMIC_RELAXED, __HIP_MEMORY_SCOPE_AGENT
#define LDS_WAIT() asm volatile("s_waitcnt lgkmcnt(0)" ::: "memory")
#define VM_WAIT() asm volatile("s_waitcnt vmcnt(0)" ::: "memory")
__device__ __forceinline__ unsigned long long rt() { return __builtin_amdgcn_s_memrealtime(); }
__device__ __forceinline__ unsigned f2bf(float f) { unsigned u = __builtin_bit_cast(unsigned, f); return (u + 0x7fffu + ((u >> 16) & 1u)) >> 16; }
__device__ __forceinline__ unsigned pk2(float lo, float hi) { return f2bf(lo) | (f2bf(hi) << 16); }

#define XB_TMO      128
#define XB_XCNT(j)  (256  + 64 * (j))
#define XB_XSUB(j)  (1280 + 64 * (j))
#define XB_XGEN(j)  (2304 + 64 * (j))
#define XB_TOP      3328
#define XB_TOPGEN   3392
#define XCD_BAR_WORDS 3456
#define XB_SPIN_CAP (1u << 18)

__device__ __forceinline__ unsigned xb_ld(unsigned* p)              { return __hip_atomic_load(p, __ATOMIC_RELAXED, __HIP_MEMORY_SCOPE_AGENT); }
__device__ __forceinline__ unsigned xb_add(unsigned* p, unsigned v) { return __hip_atomic_fetch_add(p, v, __ATOMIC_RELAXED, __HIP_MEMORY_SCOPE_AGENT); }
__device__ __forceinline__ unsigned xb_xcc_id() { return (unsigned)__builtin_amdgcn_s_getreg((3 << 11) | 20) & 0xFu; }
#define XB_SPIN(cond, bar) do { unsigned _sp = 0; while (cond) { __builtin_amdgcn_s_sleep(1); \
    if ((++_sp & 255u) == 0u) { if (xb_ld(&(bar)[XB_TMO])) break; if (_sp > XB_SPIN_CAP) { atomicAdd(&(bar)[XB_TMO], 1u); break; } } } } while (0)

struct XcdBarrier {
    unsigned* bar; unsigned x;
    volatile LAS unsigned* st;
};

__device__ __forceinline__ XcdBarrier xcd_barrier_post(unsigned* bar, volatile LAS unsigned* st) {
    XcdBarrier b; b.bar = bar; b.x = xb_xcc_id(); b.st = st;
    if (threadIdx.x == 0) st[2] = xb_add(&bar[XB_XCNT(b.x)], 1u);
    return b;
}
__device__ __forceinline__ void xcd_barrier_complete(unsigned* bar, unsigned x, unsigned& nloc, unsigned& nx) {
    const unsigned G = gridDim.x * gridDim.y * gridDim.z;
    unsigned sum, cnt, mine, sp = 0u;
    for (;;) {
        sum = 0u; cnt = 0u; mine = 0u;
#pragma unroll
        for (unsigned j = 0; j < 16; ++j) { const unsigned c = xb_ld(&bar[XB_XCNT(j)]); sum += c; cnt += (c > 0u) ? 1u : 0u; mine = (j == x) ? c : mine; }
        if (sum == G) break;
        __builtin_amdgcn_s_sleep(1);
        if ((++sp & 255u) == 0u) { if (xb_ld(&bar[XB_TMO])) break; if (sp > XB_SPIN_CAP) { atomicAdd(&bar[XB_TMO], 1u); break; } }
    }
    nloc = mine > 0u ? mine : 1u; nx = cnt > 0u ? cnt : 1u;
}

__device__ __forceinline__ void xcd_barrier(const XcdBarrier& b) {
    asm volatile("s_waitcnt vmcnt(0)" ::: "memory");
    __syncthreads();
    if (threadIdx.x == 0) {
        unsigned* bar = b.bar;
        __builtin_amdgcn_s_waitcnt(0);
        unsigned nloc = b.st[0], nx = b.st[1];
        if (nloc == 0u) { xcd_barrier_complete(bar, b.x, nloc, nx); b.st[0] = nloc; b.st[1] = nx; }
        const unsigned old = xb_add(&bar[XB_XSUB(b.x)], 1u);
        const unsigned gen = old / nloc;
        if (old + 1u == (gen + 1u) * nloc) {
            __builtin_amdgcn_fence(__ATOMIC_RELEASE, "agent");
            asm volatile("s_waitcnt vmcnt(0)" ::: "memory");
            const unsigned og = xb_add(&bar[XB_TOP], 1u);
            const unsigned tg = og / nx;
            if (og + 1u == (tg + 1u) * nx) xb_add(&bar[XB_TOPGEN], 1u);
            else XB_SPIN(xb_ld(&bar[XB_TOPGEN]) == tg, bar);
            __builtin_amdgcn_fence(__ATOMIC_ACQUIRE, "agent");
            xb_add(&bar[XB_XGEN(b.x)], 1u);
            asm volatile("s_waitcnt vmcnt(0)" ::: "memory");
        } else {
            XB_SPIN(xb_ld(&bar[XB_XGEN(b.x)]) == gen, bar);
            __builtin_amdgcn_fence(__ATOMIC_ACQUIRE, "agent");
            asm volatile("s_waitcnt vmcnt(0)" ::: "memory");
        }
    }
    __syncthreads();
}

#ifndef RES_H
#define RES_H 1
#endif

#ifndef P0_NTL
#define P0_NTL 1
#endif
#ifndef ALIGN2
#define ALIGN2 true
#endif
#ifndef ALIGN3
#define ALIGN3 true
#endif
#ifndef BH_REV
#define BH_REV 0
#endif
#ifndef QORDER
#define QORDER 0
#endif
#ifndef REV2
#define REV2 0
#endif
#ifndef REV3
#define REV3 1
#endif
#ifndef P0_SPLIT
#define P0_SPLIT 1
#endif
#ifndef PN_PERM
#define PN_PERM 0
#endif
#ifndef W_NTL
#define W_NTL 1
#endif
constexpr int NWAVES = 8;
constexpr int RING_OFF = 0, RING_BYTES = 131072;
constexpr int LDSCTL_OFF = RING_BYTES, MISC_OFF = LDSCTL_OFF + 320;
constexpr int LDS_BYTES = 147456;
static_assert(attn::LDS_BYTES + 2048 <= RING_BYTES && MISC_OFF + 128 <= LDS_BYTES, "LDS map");

struct Frame {
    LAS unsigned char* lds; volatile LAS unsigned* MISC; gu32* ctl;
    int tid, lane, wave, vcu, G;
};
__device__ __forceinline__ float wave_sum(float v) {
#pragma unroll
    for (int o = 1; o < 64; o <<= 1) v += __shfl_xor(v, o);
    return v;
}
template <int ROWMAP>
__device__ __forceinline__ void p0_transpose_item(const float* Wsrc, int K, int N, bf16* WT, int ldt, int koff, LAS float* scr, int item, int lane, const bool wt = false  ) {
    const int nblk = N / 32, kb = item / nblk, nb = item % nblk, k0 = 64 * kb, n0 = 32 * nb;
    float t[32];
#pragma unroll
    for (int i = 0; i < 32; ++i) t[i] = W_NTL ? __builtin_nontemporal_load(Wsrc + (size_t)(k0 + 2 * i + (lane >> 5)) * N + n0 + (lane & 31)) : Wsrc[(size_t)(k0 + 2 * i + (lane >> 5)) * N + n0 + (lane & 31)];
#pragma unroll
    for (int i = 0; i < 32; ++i) scr[(2 * i + (lane >> 5)) * 33 + (lane & 31)] = t[i];
    LDS_WAIT(); asm volatile("" ::: "memory");
    const int c = lane & 7; const int drow0 = (ROWMAP == 1) ? win_row_of_col(n0) : phys_of_actual(n0);
#pragma unroll
    for (int j = 0; j < 4; ++j) { const int n = (lane >> 3) + 8 * j; const LAS float* s = scr + (8 * c) * 33 + n;
        v4u o; o.x = pk2(s[0 * 33], s[1 * 33]); o.y = pk2(s[2 * 33], s[3 * 33]); o.z = pk2(s[4 * 33], s[5 * 33]); o.w = pk2(s[6 * 33], s[7 * 33]);
        bf16* const dp_ = WT + (size_t)(drow0 + n) * ldt + koff + k0 + 8 * c;
        if (wt) asm volatile("global_store_dwordx4 %0, %1, off sc1" :: "v"(dp_), "v"(o) : "memory"); else *(GAS v4u*)dp_ = o; }
    LDS_WAIT(); asm volatile("" ::: "memory");
}
template <int NR>
__device__ __forceinline__ void rms_rows_to_bf16(const float* xrow, const float* nw, bf16* orow, float* sig  , int lane) {
    f32x4 v[NR][4];
#pragma unroll
    for (int r = 0; r < NR; ++r) { const GAS f32x4* xr = (const GAS f32x4*)(xrow + (size_t)r * DM) + lane;
#pragma unroll
        for (int j = 0; j < 4; ++j) {
#if P0_NTL
            v[r][j] = __builtin_nontemporal_load((const f32x4*)(xrow + (size_t)r * DM) + lane + 64 * j);
#else
            v[r][j] = xr[64 * j];
#endif
        } }
    const GAS f32x4* wr_ = (const GAS f32x4*)nw + lane; f32x4 w[4];
#pragma unroll
    for (int j = 0; j < 4; ++j) w[j] = wr_[64 * j];
#pragma unroll
    for (int r = 0; r < NR; ++r) { float s = 0.f;
#pragma unroll
        for (int j = 0; j < 4; ++j) s += (v[r][j].x * v[r][j].x + v[r][j].y * v[r][j].y) + (v[r][j].z * v[r][j].z + v[r][j].w * v[r][j].w);
        const float sg_ = sqrtf(wave_sum(s) * (1.f / DM) + EPS); const float rstd = 1.f / sg_; if (lane == 0) sig[r] = sg_;
        GAS unsigned long long* o8 = (GAS unsigned long long*)(orow + (size_t)r * DM) + lane;
#pragma unroll
        for (int j = 0; j < 4; ++j) { const unsigned long long pk_ = (unsigned long long)pk2(v[r][j].x * rstd * w[j].x, v[r][j].y * rstd * w[j].y) | ((unsigned long long)pk2(v[r][j].z * rstd * w[j].z, v[r][j].w * rstd * w[j].w) << 32);
#ifdef P0_NT
            __builtin_nontemporal_store(pk_, (unsigned long long*)(orow + (size_t)r * DM) + lane + 64 * j);
#else
            o8[64 * j] = pk_;
#endif
        } }
}

struct BatchOrder : pg8::StaticOrder {
    unsigned* ctlw;
    __device__ __forceinline__ void done(const pg8::Unit& u) const {
        if (ctlw && u.pn >= 20) { asm volatile("s_waitcnt vmcnt(0)" ::: "memory"); if ((threadIdx.x & 63) == 0) (void)xb_add(ctlw + CW_BRDY + 64 * (u.pm >> 3), 1u); } }
};
struct PanelOrder : pg8::StaticOrder {
    unsigned* ready; unsigned need; unsigned* barw;
    __device__ __forceinline__ void a_ready(const pg8::Unit& u) const {
        if (need) {
            if (threadIdx.x < 64) { if (threadIdx.x == 0) { XB_SPIN(xb_ld(ready + 64 * u.pm) < need, barw); }
                __builtin_amdgcn_fence(__ATOMIC_ACQUIRE, "agent"); asm volatile("s_waitcnt vmcnt(0)" ::: "memory"); }
            asm volatile("" ::: "memory"); __builtin_amdgcn_s_barrier(); asm volatile("" ::: "memory"); } }
};
struct Args { const float* in[10]; float* out; unsigned char* ws; int ph_lo, ph_hi; };

__global__ void __launch_bounds__(NWAVES * 64, 2) hybrid_fwd(Args args) {
    extern __shared__ __attribute__((aligned(16))) unsigned char lds[];
    Frame F;
    F.lds = (LAS unsigned char*)lds; F.MISC = (volatile LAS unsigned*)(F.lds + MISC_OFF);
    F.tid = threadIdx.x; F.lane = F.tid & 63; F.wave = __builtin_amdgcn_readfirstlane(F.tid >> 6);
    F.G = gridDim.x; { const int bx = blockIdx.x; F.vcu = (F.G % 8 == 0) ? (bx % 8) * (F.G / 8) + bx / 8 : bx; }
    unsigned char* ws = args.ws; F.ctl = (gu32*)(ws + WS_CTL);
    for (int u = F.tid; u < (LDS_BYTES - LDSCTL_OFF) / 4; u += NWAVES * 64) ((LAS unsigned*)(F.lds + LDSCTL_OFF))[u] = 0u;
    __syncthreads();
    const int lo = args.ph_lo, hi = args.ph_hi;
    const bool wok = !__syncthreads_or((__builtin_fabsf(args.in[1][F.tid]) < 1e-3f) || (__builtin_fabsf(args.in[1][F.tid + NWAVES * 64]) < 1e-3f));
    if (lo <= 2 && 2 < hi) attn::moba_tables((LAS float*)(F.lds + LDSCTL_OFF + 10240), args.in[6], F.tid);
    const bool multi = (hi - lo) > 1;
    XcdBarrier bar; bar.bar = (unsigned*)(F.ctl + CW_BAR); bar.x = 0; bar.st = nullptr;
    if (multi) bar = xcd_barrier_post((unsigned*)(F.ctl + CW_BAR), F.MISC + 8);
#define IN(k) (lo <= (k) && (k) < hi)
    unsigned long long* stamps = (unsigned long long*)(ws + 128 * 1024);
#ifndef PT_K
#define PT_K (-1)
#endif
#ifndef PT_KIND
#define PT_KIND 0
#endif
#ifndef PT_AMP
#define PT_AMP 16
#endif
#define STAMP(k) do { if (PT_K >= 0) { if (F.tid == 0) __hip_atomic_store(stamps + (k) * 256 + blockIdx.x, rt(), __ATOMIC_RELAXED, __HIP_MEMORY_SCOPE_AGENT); } } while (0)
#ifndef PT_AT
#define PT_AT PT_K
#endif
#define PTDELAY(kat) do { const int kb = PT_K; if (PT_AT == (kat) && PT_K >= 0 && blockIdx.x == 0 && F.wave == 0) { \
        unsigned long long mn_ = ~0ull, mx_ = 0ull; \
        for (int j_ = F.lane; j_ < F.G; j_ += 64) { const unsigned long long v_ = __hip_atomic_load(stamps + ((PT_KIND == 3) ? 0 : (2 * (kb) + 1)) * 256 + j_, __ATOMIC_RELAXED, __HIP_MEMORY_SCOPE_AGENT); mn_ = v_ < mn_ ? v_ : mn_; mx_ = v_ > mx_ ? v_ : mx_; } \
        for (int o_ = 1; o_ < 64; o_ <<= 1) { const unsigned long long a_ = __shfl_xor(mn_, o_), b_ = __shfl_xor(mx_, o_); mn_ = a_ < mn_ ? a_ : mn_; mx_ = b_ > mx_ ? b_ : mx_; } \
        const unsigned long long ex_ = __hip_atomic_load(stamps + (2 * (kb) + 2) * 256, __ATOMIC_RELAXED, __HIP_MEMORY_SCOPE_AGENT), pv_ = __hip_atomic_load(stamps + (2 * (kb)) * 256, __ATOMIC_RELAXED, __HIP_MEMORY_SCOPE_AGENT); \
        const unsigned long long X_ = (PT_KIND == 0 || PT_KIND == 3) ? (mx_ - mn_) : (PT_KIND == 1) ? (ex_ - mx_) : (PT_KIND == 4) ? (mx_ - __hip_atomic_load(stamps, __ATOMIC_RELAXED, __HIP_MEMORY_SCOPE_AGENT)) : (mx_ - pv_);         \
        const unsigned long long t0_ = rt(); while (rt() - t0_ < (unsigned long long)PT_AMP * X_) __builtin_amdgcn_s_sleep(8); } \
      if (PT_AT == (kat)) __syncthreads(); } while (0)
    STAMP(0);
#ifndef DUP_MASK
#define DUP_MASK 0
#endif
#define NREP(k) (((DUP_MASK >> (k)) & 1) ? 2 : 1)
#define BOTH(k) (IN(k) && IN((k) + 1))
    const float* x = args.in[0];
    bf16* Wt_in = (bf16*)(ws + WS_WIN); bf16* Wt_up = (bf16*)(ws + WS_WUP); bf16* Wt_out = (bf16*)(ws + WS_WOUT);
    bf16* Hb = (bf16*)(ws + WS_H);
    bf16* Ob = RES_H ? (bf16*)args.out : Hb;
    float* SIGp = (float*)(ws + WS_SIG);

#ifndef NPASS
#define NPASS 1
#endif
#ifndef WARM_NEXT
#define WARM_NEXT 0
#endif
#ifndef STAG2
#define STAG2 0
#endif
#ifndef STAG3
#define STAG3 0
#endif
#ifndef SB_CHAIN
#define SB_CHAIN 1
#endif
#ifndef MB_CHAIN
#define MB_CHAIN 1
#endif
#ifndef PANEL_BAR
#define PANEL_BAR 1
#endif
static_assert(RES_H == 1, "the padded O panel layout lives in the output buffer");
#ifndef ALIGNED
#define ALIGNED 1
#endif
#ifndef BARX
#define BARX 1
#endif
#if BARX == 1
#define GBAR() xcd_barrier(bar)
#else
#define GBAR() do { for (int bx_ = 0; bx_ < BARX; ++bx_) xcd_barrier(bar); } while (0)
#endif
    if (lo == 0 && multi) { if (F.tid == 0) { unsigned nloc_ = 1u, nx_ = 1u; xcd_barrier_complete((unsigned*)(F.ctl + CW_BAR), xb_xcc_id(), nloc_, nx_); F.MISC[8] = nloc_; F.MISC[9] = nx_;
            bool a_ = ALIGNED && F.G == 256; unsigned c_[8];
            for (int j_ = 0; j_ < 8; ++j_) c_[j_] = xb_ld((unsigned*)(F.ctl + CW_BAR) + XB_XCNT(j_));
            for (int j_ = 0; j_ < 8; ++j_) a_ = a_ && (c_[j_] == 32u);
            F.MISC[11] = a_ ? 1u : 0u; }
        __syncthreads(); }
#define AL ((lo == 0 && multi) && (__builtin_amdgcn_readfirstlane((int)F.MISC[11]) != 0))
#define cid (AL ? (int)((xb_xcc_id() & 7u) + 8u * (unsigned)__builtin_amdgcn_readfirstlane((int)F.MISC[10])) : (int)blockIdx.x)
#define QREMAP(u) ((((8u * ((u) >> 7)) + (((u) >> 3) & 7u)) << 4) | ((((u) >> 6) & 1u) * 8u + ((u) & 7u)))
#ifndef NO_P0
    if (IN(0)) {
        LAS float* scr = (LAS float*)(F.lds + RING_OFF + F.wave * 16384);
        const int gw = F.vcu * NWAVES + F.wave, NGW = F.G * NWAVES;
        constexpr int I_IN = (DM / 64) * (INW / 32), I_UP = (W / 64) * (DM / 32), I_OUT = (DM / 64) * (DM / 32);
        constexpr int NITEMS = I_IN + 2 * I_UP + I_OUT;
        if (AL) {
            const int r_ = cid >> 3, x_ = cid & 7;
#define P0_RG(id_) do { const int m = 4 * (1024 * x_ + (id_)); rms_rows_to_bf16<4>(x + (size_t)m * DM, args.in[1], Hb + (size_t)m * DM, SIGp + m, F.lane); } while (0)
#define P0_PUB(n_) do { asm volatile("s_waitcnt vmcnt(0)" ::: "memory"); if (F.lane == 0) (void)xb_add((unsigned*)(F.ctl + CW_HRDY + 64 * (16 * x_ + (r_ >> 1))), (unsigned)(n_)); } while (0)
            if (F.wave < 4) { for (int k_ = 0; k_ < 6; ++k_) P0_RG(32 * r_ + 6 * F.wave + k_); P0_PUB(6); }
            else { for (int it = F.vcu * 4 + (F.wave - 4); it < NITEMS; it += F.G * 4) { int r = it;
                    if (r < I_IN) { p0_transpose_item<1>(args.in[2], DM, INW, Wt_in, DM, 0, scr, r, F.lane, true); continue; } r -= I_IN;
                    if (r < I_UP) { p0_transpose_item<0>(args.in[7], W, DM, Wt_up, DM, 0, scr, r, F.lane, true); continue; } r -= I_UP;
                    if (r < I_UP) { p0_transpose_item<0>(args.in[8], W, DM, Wt_up, DM, W, scr, r, F.lane, true); continue; } r -= I_UP;
                    p0_transpose_item<0>(args.in[9], DM, DM, Wt_out, DM, 0, scr, r, F.lane, true); }
                asm volatile("s_waitcnt vmcnt(0)" ::: "memory"); if (F.lane == 0) (void)xb_add((unsigned*)(F.ctl + CW_WCNT), 1u);
                for (int k_ = 0; k_ < 2; ++k_) P0_RG(32 * r_ + 24 + 2 * (F.wave - 4) + k_); P0_PUB(2); }
#undef P0_RG
#undef P0_PUB
        } else
        for (int rep = 0; rep < NREP(0); ++rep) {
        if (P0_SPLIT && F.wave < 4) for (int m = 4 * gw; m < M; m += 4 * NGW) rms_rows_to_bf16<4>(x + (size_t)m * DM, args.in[1], Hb + (size_t)m * DM, SIGp + m, F.lane);
        for (int it = gw; it < NITEMS; it += NGW) { int r = it;
            if (r < I_IN) { p0_transpose_item<1>(args.in[2], DM, INW, Wt_in, DM, 0, scr, r, F.lane); continue; } r -= I_IN;
            if (r < I_UP) { p0_transpose_item<0>(args.in[7], W, DM, Wt_up, DM, 0, scr, r, F.lane); continue; } r -= I_UP;
            if (r < I_UP) { p0_transpose_item<0>(args.in[8], W, DM, Wt_up, DM, W, scr, r, F.lane); continue; } r -= I_UP;
            p0_transpose_item<0>(args.in[9], DM, DM, Wt_out, DM, 0, scr, r, F.lane); }
        if (!(P0_SPLIT && F.wave < 4)) for (int m = 4 * gw; m < M; m += 4 * NGW) rms_rows_to_bf16<4>(x + (size_t)m * DM, args.in[1], Hb + (size_t)m * DM, SIGp + m, F.lane);
        }
        STAMP(1); if (BOTH(0) && !AL) GBAR(); STAMP(2); PTDELAY(0);
    }
#endif
#ifndef NO_P1
    if (IN(1)) {
        pg8::Gemm g{Hb, Wt_in, M, INW, DM, DM, DM}; BatchOrder S; S.init(M, INW, F.G, cid, 1, PN_PERM); S.ctlw = AL ? (unsigned*)F.ctl : nullptr;
        if (AL) {
            pg8::Unit ua_, ub_; const int pa_ = S.next(0, ua_) ? ua_.pm : 0, pb_ = S.next(6, ub_) ? ub_.pm : pa_;
            if (F.tid == 0) { unsigned* const cw_ = (unsigned*)F.ctl; XB_SPIN(xb_ld(cw_ + CW_HRDY + 64 * pa_) < 64u, cw_ + CW_BAR); XB_SPIN(xb_ld(cw_ + CW_HRDY + 64 * pb_) < 64u, cw_ + CW_BAR); XB_SPIN(xb_ld(cw_ + CW_WCNT) < 1024u, cw_ + CW_BAR);
                __builtin_amdgcn_fence(__ATOMIC_ACQUIRE, "agent"); asm volatile("s_waitcnt vmcnt(0)" ::: "memory"); }
            __syncthreads(); }
        pg8::EpiProj E{ws, args.in[3], args.in[4], args.in[5], 0};
#ifdef GT_PROBE
        if (blockIdx.x == 0 && F.tid == 0) ((volatile LAS unsigned long long*)(F.lds + 132160))[4] = rt();
#endif
#ifdef STAGGER_TICKS
        { const unsigned long long t0_ = rt(); const unsigned long long dly_ = (unsigned long long)((blockIdx.x >> 3) & 3) * STAGGER_TICKS; while (rt() - t0_ < dly_) __builtin_amdgcn_s_sleep(4); }
#endif
        for (int rep = 0; rep < NREP(1); ++rep) {
#ifdef DUP_NOSTORE
        if (rep == 1) E.nostore = 1;
#endif
        pg8::gemm_phase<pg8::EpiProj, BatchOrder, true, true>(F.lds + RING_OFF, g, S, E); }
#ifdef GT_PROBE
        if (blockIdx.x == 0 && F.tid == 0) ((volatile LAS unsigned long long*)(F.lds + 132160))[5] = rt();
#endif
        if (BOTH(1) && F.tid == 0) {
            const unsigned myx_ = xb_xcc_id() & 7u; int qi = 0; unsigned d_[2];
            for (int k_ = 0; k_ < 2; ++k_) { d_[k_] = 0xffffffffu; while (qi < (AL ? 1 : 8)) { const unsigned q_ = (myx_ + (unsigned)qi) & 7u;
                const unsigned u_ = __hip_atomic_fetch_add((unsigned*)(F.ctl + CW_QUEUE + 64 * q_), 1u, __ATOMIC_RELAXED, __HIP_MEMORY_SCOPE_AGENT); if (u_ < 256u) { d_[k_] = (q_ << 8) | QREMAP(u_); break; } ++qi; } }
            F.MISC[20] = d_[0]; F.MISC[21] = d_[1]; F.MISC[22] = (unsigned)qi; F.MISC[23] = 1u; }
        STAMP(3); if (BOTH(1) && !AL) GBAR(); STAMP(4); PTDELAY(1);
    }
#endif
#ifndef NO_P2
    if (IN(2)) {
        const bf16* QA = (const bf16*)(ws + WS_P); const bf16* KA = QA + (size_t)M * W; const bf16* VA = KA + (size_t)M * W; const bf16* ZA = VA + (size_t)M * W;
        const bf16* QB_ = ZA + (size_t)M * W; const bf16* KB_ = QB_ + (size_t)M * W; const bf16* VB_ = KB_ + (size_t)M * W; const bf16* ZB_ = VB_ + (size_t)M * W;
        LAS float* tabs = (LAS float*)(F.lds + LDSCTL_OFF + 10240);
        const unsigned myx = xb_xcc_id() & 7u;
        const unsigned dummy = (unsigned)__builtin_amdgcn_readfirstlane((unsigned)(uintptr_t)(F.lds + LDSCTL_OFF + 2048) + (unsigned)F.wave * 1024u);
#pragma unroll 1
        for (int pass = 0; pass < NREP(2); ++pass) {
#define POP_DESC(dst) do { dst = 0xffffffffu; while (qi < (AL ? 1 : 8)) { const unsigned q_ = (myx + (unsigned)qi) & 7u; \
            const unsigned u_ = __hip_atomic_fetch_add((unsigned*)(F.ctl + CW_QUEUE + 64 * q_ + 1024 * pass), 1u, __ATOMIC_RELAXED, __HIP_MEMORY_SCOPE_AGENT); if (u_ < 256u) { dst = (q_ << 8) | QREMAP(u_); break; } ++qi; } } while (0)
        if (F.tid == 0 && !(pass == 0 && F.MISC[23] == 1u)) { int qi = 0; unsigned d0_, d1_; POP_DESC(d0_); POP_DESC(d1_); F.MISC[20] = d0_; F.MISC[21] = d1_; F.MISC[22] = (unsigned)qi; }
        __syncthreads(); unsigned cur = (unsigned)__builtin_amdgcn_readfirstlane((int)F.MISC[20]), nxt = (unsigned)__builtin_amdgcn_readfirstlane((int)F.MISC[21]); __syncthreads();
        unsigned nok = 1u;
#pragma unroll 1
        while (cur != 0xffffffffu) {
#define DECODE(d, is_sb, b, h, qb) const int cls_##b = (int)(((d) & 255u) >> 4), bh_##b = 16 * (int)((d) >> 8) + (BH_REV ? 15 - (int)((d) & 15u) : (int)((d) & 15u)); const int b = bh_##b >> 3, h = bh_##b & 7; \
            const bool is_sb = QORDER ? (cls_##b >= 8) : ((cls_##b >= 6 && cls_##b <= 12) || cls_##b == 14); const int qb = QORDER ? (7 - (cls_##b & 7)) : ((cls_##b < 6) ? 7 - cls_##b : (cls_##b <= 12) ? 13 - cls_##b : (cls_##b == 13) ? 1 : 0)
            if (WARM_NEXT && nxt != 0xffffffffu) { DECODE(nxt, nsb, nb, nh, nqb); const long r0 = (long)nb * SEQ, rq = r0 + nqb * 256;
                if (!nsb) { attn::warm_rows(KA + nh * 64, r0, 3, dummy, F.wave, F.lane); attn::warm_rows(VA + nh * 64, r0, 1, dummy, F.wave, F.lane); attn::warm_rows(QA + nh * 64, rq, 4, dummy, F.wave, F.lane); attn::warm_rows(ZA + nh * 64, rq, 4, dummy, F.wave, F.lane); }
                else { attn::warm_rows(KB_ + nh * 64, rq, 4, dummy, F.wave, F.lane); attn::warm_rows(VB_ + nh * 64, rq, 4, dummy, F.wave, F.lane); attn::warm_rows(QB_ + nh * 64, rq, 4, dummy, F.wave, F.lane); attn::warm_rows(ZB_ + nh * 64, rq, 4, dummy, F.wave, F.lane); } }
#define READY() do { nok = 1u; if (AL) { if (F.tid == 0) { unsigned rd_ = F.MISC[27]; unsigned* const brdy_ = (unsigned*)(F.ctl + CW_BRDY); const unsigned cl_ = (cur >> 3) & 1u; \
                if (!((rd_ >> cl_) & 1u)) { XB_SPIN(xb_ld(brdy_ + 64 * (2u * (cur >> 8) + cl_)) < 256u, (unsigned*)(F.ctl + CW_BAR)); __builtin_amdgcn_fence(__ATOMIC_ACQUIRE, "agent"); asm volatile("s_waitcnt vmcnt(0)" ::: "memory"); rd_ |= 1u << cl_; } \
                unsigned nk_ = 1u; if (nxt != 0xffffffffu) { const unsigned nl_ = (nxt >> 3) & 1u; \
                    if (!((rd_ >> nl_) & 1u)) { if (xb_ld(brdy_ + 64 * (2u * (nxt >> 8) + nl_)) >= 256u) { __builtin_amdgcn_fence(__ATOMIC_ACQUIRE, "agent"); asm volatile("s_waitcnt vmcnt(0)" ::: "memory"); rd_ |= 1u << nl_; } else nk_ = 0u; } } \
                F.MISC[27] = rd_; F.MISC[28] = nk_; } \
            __syncthreads(); nok = (unsigned)__builtin_amdgcn_readfirstlane((int)F.MISC[28]); } } while (0)
#define ADVANCE() do { if (F.tid == 0) { unsigned nn = 0xffffffffu; if (nxt != 0xffffffffu) { int qi = (int)F.MISC[22]; POP_DESC(nn); F.MISC[22] = (unsigned)qi; } F.MISC[20] = nn; } \
            __syncthreads(); cur = nxt; nxt = (unsigned)__builtin_amdgcn_readfirstlane((int)F.MISC[20]); } while (0)
            { DECODE(cur, csb, cb, ch, cqb);
                if (!csb) {
                    attn::bf16x8 qc[4] = {}; bool pre = false; int s0 = 0;
#pragma unroll 1
                    for (;;) { DECODE(cur, csb3, cb3, ch3, cqb3); bool chain = false; int s0n = 0; READY();
                        if (MB_CHAIN && nok && nxt != 0xffffffffu) { DECODE(nxt, nsb3, nb3, nh3, nqb3); chain = !nsb3; }
                        attn::moba_unit_t<8>(cb3, ch3, cqb3, QA, KA, VA, ZA, Ob, (const float*)(ws + WS_KSUM) + (size_t)(cb3 * 8 + ch3) * NBLK * 64, tabs + ch3 * 132, (LAS char*)(F.lds + RING_OFF), AL ? (unsigned*)(F.ctl + CW_ORDY + 64 * (cb3 * 8 + cqb3)) : (unsigned*)nullptr, pre, qc, s0, (MB_CHAIN && nok) ? nxt : 0xffffffffu, s0n);
                        ADVANCE(); pre = chain; s0 = s0n; if (!chain) break; } }
                else {
                    bool pre = false;
#pragma unroll 1
                    for (;;) { DECODE(cur, csb2, cb2, ch2, cqb2); bool chain = false; READY();
                        if (SB_CHAIN && nok && nxt != 0xffffffffu) { DECODE(nxt, nsb, nb, nh, nqb); chain = nsb; }
                        attn::sb_unit_w(cb2, ch2, cqb2, QB_, KB_, VB_, ZB_, Ob + W, (LAS char*)(F.lds + RING_OFF), AL ? (unsigned*)(F.ctl + CW_ORDY + 64 * (cb2 * 8 + cqb2)) : (unsigned*)nullptr, pre, (SB_CHAIN && nok) ? nxt : 0xffffffffu);
                        ADVANCE(); pre = chain; if (!chain) break; } } }
#undef ADVANCE
        }
#undef POP_DESC
#undef DECODE
        }
#ifdef UT_PROBE
        if (blockIdx.x == 0 && F.tid == 0) { volatile LAS unsigned long long* u_ = (volatile LAS unsigned long long*)(F.lds + 132096); const unsigned long long X_ = u_[UT_B] - u_[UT_A];
            const unsigned long long t0_ = rt(); while (rt() - t0_ < (unsigned long long)UT_AMP * X_) __builtin_amdgcn_s_sleep(8); }
        __syncthreads();
#endif
        STAMP(5); if (BOTH(2) && !AL) GBAR(); STAMP(6); PTDELAY(2);
    }
#endif
#ifndef NO_P3
    if (IN(3)) {
        pg8::Gemm g{Ob, Wt_up, M, DM, DM, DM, DM, OPAN * 2, 0};     PanelOrder S; S.init(M, DM, F.G, cid, NREP(3), 0, REV2);
        S.ready = (unsigned*)(F.ctl + CW_ORDY); S.need = AL ? 128u : 0u; S.barw = (unsigned*)(F.ctl + CW_BAR);
        bf16* const Y0_ = (bf16*)(ws + WS_Y); bf16* const Y1_ = AL ? (bf16*)(ws + WS_P + 4 * (32 * MiB)) : Y0_ + (size_t)128 * DM; const size_t ypan_ = AL ? (size_t)131072 : (size_t)256 * DM;
        pg8::EpiY E{(const bf16*)(ws + WS_GR), (const bf16*)(ws + WS_GB), Y0_, (LAS unsigned*)(F.lds + LDSCTL_OFF + 2048 + F.wave * 1024), Y1_, ypan_};
#if STAG2
        if ((blockIdx.x >> 3) & 1) { const unsigned long long t0_ = rt(); while (rt() - t0_ < (unsigned long long)STAG2) __builtin_amdgcn_s_sleep(4); }
#endif
        pg8::gemm_phase<pg8::EpiY, PanelOrder, ALIGN2, true>(F.lds + RING_OFF, g, S, E);
        STAMP(7);
        if (BOTH(3)) {
            pg8::Unit u0_; const bool g4_ = PANEL_BAR && AL && S.next(0, u0_);
            if (g4_) {
                asm volatile("s_waitcnt vmcnt(0)" ::: "memory"); __syncthreads();
                if (F.tid == 0) { unsigned* cnt_ = (unsigned*)(F.ctl + CW_QBAR + 64 * u0_.pm);
                    (void)xb_add(cnt_, 1u);
                    XB_SPIN(xb_ld(cnt_) < 4u, (unsigned*)(F.ctl + CW_BAR));
                    __builtin_amdgcn_fence(__ATOMIC_ACQUIRE, "agent"); asm volatile("s_waitcnt vmcnt(0)" ::: "memory"); }
                __syncthreads();
            } else GBAR();
        }
        STAMP(8); PTDELAY(3);
    }
#endif
#ifndef NO_P4
    if (IN(4)) {
        pg8::Gemm g{(const bf16*)(ws + WS_Y), Wt_out, M, DM, DM, DM, DM, AL ? (size_t)(256 * 1024) : (size_t)0, AL ? (size_t)4 * (32 * MiB) : (size_t)0};     pg8::StaticOrder S; S.init(M, DM, F.G, cid, 1, 0, REV3);
        pg8::EpiOut E{x, args.out, Hb, SIGp, args.in[1], (RES_H && wok) ? 1 : 0};
#if STAG3
        if ((blockIdx.x >> 3) & 1) { const unsigned long long t0_ = rt(); while (rt() - t0_ < (unsigned long long)STAG3) __builtin_amdgcn_s_sleep(4); }
#endif
        for (int rep = 0; rep < NREP(4); ++rep)
        pg8::gemm_phase<pg8::EpiOut, pg8::StaticOrder, ALIGN3, true>(F.lds + RING_OFF, g, S, E);
    }
#endif
    if (PT_K == 4) { STAMP(9); xcd_barrier(bar); STAMP(10); PTDELAY(4); }
#ifdef GT_PROBE
    if (blockIdx.x == 0 && F.tid == 0) { volatile LAS unsigned long long* u_ = (volatile LAS unsigned long long*)(F.lds + 132160); const unsigned long long X_ = u_[GT_B] - u_[GT_A];
        const unsigned long long t0_ = rt(); while (rt() - t0_ < (unsigned long long)GT_AMP * X_) __builtin_amdgcn_s_sleep(8); }
    __syncthreads();
#endif
#undef IN
#undef BOTH
}

__global__ void noop_kernel(int* p) { if (threadIdx.x == 1000) p[0] = 1; }
#ifndef MK_CUTS
#define MK_CUTS 1
#endif
extern "C" void kernel_launch(void* const* d_in, const int* in_sizes, int n_in, void* d_out, int out_size, void* d_ws, size_t ws_size, hipStream_t stream) {
    static int grid = 0;
    if (grid == 0) {
        if (n_in != 10 || in_sizes[0] != M * DM || out_size != M * DM || ws_size < WS_END) { fprintf(stderr, "kernel_launch: unexpected shapes / workspace (%d inputs, x %d, out %d, ws %zu)\n", n_in, n_in > 0 ? in_sizes[0] : -1, out_size, ws_size); grid = -1; return; }
        int dev = 0, cus = 0, per_cu = 0;
        if (hipGetDevice(&dev) != hipSuccess || hipDeviceGetAttribute(&cus, hipDeviceAttributeMultiprocessorCount, dev) != hipSuccess) { grid = -1; return; }
        if (hipFuncSetAttribute((const void*)hybrid_fwd, hipFuncAttributeMaxDynamicSharedMemorySize, LDS_BYTES) != hipSuccess) { fprintf(stderr, "kernel_launch: hipFuncSetAttribute failed\n"); grid = -1; return; }
        if (hipOccupancyMaxActiveBlocksPerMultiprocessor(&per_cu, (const void*)hybrid_fwd, NWAVES * 64, LDS_BYTES) != hipSuccess || per_cu < 1) fprintf(stderr, "kernel_launch: note: occupancy query reports %d\n", per_cu);
        (void)hipGetLastError();
        grid = cus;
    }
    if (grid < 0) return;
#ifdef XMEMSET
    for (int i = 0; i < XMEMSET; ++i) (void)hipMemsetAsync((char*)d_ws + WS_CTL, 0, CTL_ZERO_BYTES, stream);
#endif
#ifdef XKERNEL
    for (int i = 0; i < XKERNEL; ++i) hipLaunchKernelGGL(noop_kernel, dim3(1), dim3(64), 0, stream, (int*)d_ws + 300000);
#endif
    if (hipMemsetAsync((char*)d_ws + WS_CTL, 0, CTL_ZERO_BYTES, stream) != hipSuccess) return;
    Args a{};
    for (int i = 0; i < 10; ++i) a.in[i] = (const float*)d_in[i];
    a.out = (float*)d_out; a.ws = (unsigned char*)d_ws;
    if (MK_CUTS == 1) { a.ph_lo = 0; a.ph_hi = 5; for (int pass = 0; pass < NPASS; ++pass) { if (pass) hipMemsetAsync((char*)d_ws + WS_CTL, 0, CTL_ZERO_BYTES, stream); hipLaunchKernelGGL(hybrid_fwd, dim3(grid), dim3(NWAVES * 64), LDS_BYTES, stream, a); } }
    else for (int p = 0; p < 5; ++p) { a.ph_lo = p; a.ph_hi = p + 1; hipLaunchKernelGGL(hybrid_fwd, dim3(grid), dim3(NWAVES * 64), LDS_BYTES, stream, a); }
}
```
